# Optimizing an MI355X kernel written in HIP

```python
import math
import jax, jax.numpy as jnp
from jax import lax
import numpy as np

D_MODEL = 1024
BATCH = 2
SEQ = 8192
DEPTH = 1
DEC_BATCH = 128
DEC_SEQ = 1
PAST_LEN = 2048
PAGE_SIZE = 128

CONV_CH = D_MODEL // 2
CONV_WIDTH = 31
N_HEADS = 4
HEAD_DIM = 64
K_DIM = 2 * HEAD_DIM
V_DIM = 2 * HEAD_DIM
ATTN_CH = N_HEADS * V_DIM
MIX_WIDTH = CONV_CH + ATTN_CH
IN_WIDTH = 2 * CONV_CH + 2 * N_HEADS * K_DIM + N_HEADS * V_DIM
ROT_DIM = HEAD_DIM // 4
ROPE_THETA = 500000.0
D_FF = -(-8 * D_MODEL // (3 * 256)) * 256
Q_BLOCK = 128
NORM_EPS = 1e-6
NEG_INF = -1e30

kernel_name = "hybrid_conformerconv_diffattn_decode"


def rmsnorm(x, g):
    xf = x.astype(jnp.float32)
    y = xf * lax.rsqrt(jnp.mean(xf * xf, axis=-1, keepdims=True) + NORM_EPS)
    return (y * g.astype(jnp.float32)).astype(x.dtype)


def layernorm(x, g, b):
    xf = x.astype(jnp.float32)
    mu = jnp.mean(xf, axis=-1, keepdims=True)
    xc = xf - mu
    y = xc * lax.rsqrt(jnp.mean(xc * xc, axis=-1, keepdims=True) + NORM_EPS)
    return (y * g.astype(jnp.float32) + b.astype(jnp.float32)).astype(x.dtype)


def lambda_init_for(layer_idx):
    return 0.8 - 0.6 * math.exp(-0.3 * layer_idx)


def partial_rope(x, pos):
    half = ROT_DIM // 2
    inv_freq = ROPE_THETA ** (-jnp.arange(0, ROT_DIM, 2, dtype=jnp.float32) / ROT_DIM)
    ang = pos.astype(jnp.float32)[:, None] * inv_freq[None, :]
    cos = jnp.cos(ang)[None, :, None, None, :].astype(x.dtype)
    sin = jnp.sin(ang)[None, :, None, None, :].astype(x.dtype)
    x1, x2, rest = x[..., :half], x[..., half:ROT_DIM], x[..., ROT_DIM:]
    return jnp.concatenate([x1 * cos - x2 * sin, x2 * cos + x1 * sin, rest], axis=-1)


def causal_dwconv(u_ext, w, b):
    y = lax.conv_general_dilated(u_ext, w[:, None, :], window_strides=(1,), padding='VALID',
                                 dimension_numbers=('NWC', 'WIO', 'NWC'),
                                 feature_group_count=CONV_CH)
    return y + b


def diff_attn_core(q, k, v, q_pos, k_pos, lam):
    s = jnp.einsum('bqhcd,bkhcd->bhcqk', q, k).astype(jnp.float32) * (HEAD_DIM ** -0.5)
    mask = k_pos[None, :] <= q_pos[:, None]
    s = jnp.where(mask, s, NEG_INF)
    p = jax.nn.softmax(s, axis=-1)
    a = p[:, :, 0] - lam * p[:, :, 1]
    return jnp.einsum('bhqk,bkhd->bqhd', a.astype(v.dtype), v)


def hybrid_layer(x, c, conv_past, k_past, v_past, q_pos, k_pos, lam_init, blockwise,
                 g_mix, g_ffn, w_ada, b_ada, w_in, dw_w, dw_b, cln_g, cln_b,
                 lq1, lk1, lq2, lk2, subln_g, w_out, w_ffn_in, w_ffn_out):
    B, T, _ = x.shape
    mods = jnp.split(jax.nn.silu(c) @ w_ada + b_ada, 6, axis=-1)
    sh_m, sc_m, gt_m, sh_f, sc_f, gt_f = [m[:, None, :] for m in mods]

    h = rmsnorm(x, g_mix) * (1 + sc_m) + sh_m
    proj = h @ w_in
    conv_in, q, k, v = jnp.split(
        proj, [2 * CONV_CH, 2 * CONV_CH + N_HEADS * K_DIM, 2 * CONV_CH + 2 * N_HEADS * K_DIM], axis=-1)

    u = conv_in[..., :CONV_CH] * jax.nn.sigmoid(conv_in[..., CONV_CH:])
    u_ext = jnp.concatenate([conv_past, u], axis=1)
    conv_out = jax.nn.silu(layernorm(causal_dwconv(u_ext, dw_w, dw_b), cln_g, cln_b))
    new_conv = u_ext[:, -(CONV_WIDTH - 1):]

    q = partial_rope(q.reshape(B, T, N_HEADS, 2, HEAD_DIM), q_pos)
    k = partial_rope(k.reshape(B, T, N_HEADS, 2, HEAD_DIM), q_pos)
    v = v.reshape(B, T, N_HEADS, V_DIM)
    k_rows = k.reshape(B, T, N_HEADS, K_DIM)
    lam = (jnp.exp(jnp.sum(lq1.astype(jnp.float32) * lk1.astype(jnp.float32)))
           - jnp.exp(jnp.sum(lq2.astype(jnp.float32) * lk2.astype(jnp.float32))) + lam_init)
    if k_past is None:
        k_all, v_all = k, v
    else:
        k_all = jnp.concatenate([k_past.reshape(B, -1, N_HEADS, 2, HEAD_DIM), k], axis=1)
        v_all = jnp.concatenate([v_past, v], axis=1)
    if blockwise:
        nq = T // Q_BLOCK
        qb = q.reshape(B, nq, Q_BLOCK, N_HEADS, 2, HEAD_DIM).swapaxes(0, 1)
        qpb = q_pos.reshape(nq, Q_BLOCK)
        o = lax.map(lambda a: diff_attn_core(a[0], k_all, v_all, a[1], k_pos, lam), (qb, qpb))
        o = o.swapaxes(0, 1).reshape(B, T, N_HEADS, V_DIM)
    else:
        o = diff_attn_core(q, k_all, v_all, q_pos, k_pos, lam)
    o = (rmsnorm(o, subln_g) * (1 - lam_init)).reshape(B, T, ATTN_CH)

    mix = jnp.concatenate([conv_out, o], axis=-1) @ w_out
    x = x + gt_m * mix

    h2 = rmsnorm(x, g_ffn) * (1 + sc_f) + sh_f
    gg, uu = jnp.split(h2 @ w_ffn_in, 2, axis=-1)
    x = x + gt_f * ((jax.nn.silu(gg) * uu) @ w_ffn_out)
    return x, k_rows, v, new_conv


def setup_inputs(seed: int = 0) -> dict:
    key = jax.random.key(seed)
    ks = jax.random.split(key, 32)
    f32 = jnp.float32
    n_pages = PAST_LEN // PAGE_SIZE
    n_used = DEC_BATCH * n_pages
    n_pool = n_used + -(-n_used // 4)
    nrm = lambda k, shape, s: jax.random.normal(k, shape, f32) * s
    page_table = jax.random.permutation(ks[0], n_pool)[:n_used].reshape(DEC_BATCH, n_pages).astype(jnp.int32)
    return {
        "x_prompt": nrm(ks[1], (BATCH, SEQ, D_MODEL), 1.0),
        "x_sample": nrm(ks[2], (DEC_BATCH, DEC_SEQ, D_MODEL), 1.0),
        "cache_k": nrm(ks[3], (DEPTH, n_pool, PAGE_SIZE, N_HEADS, K_DIM), 1.0),
        "cache_v": nrm(ks[4], (DEPTH, n_pool, PAGE_SIZE, N_HEADS, V_DIM), 1.0),
        "state_conv": nrm(ks[5], (DEPTH, DEC_BATCH, CONV_WIDTH - 1, CONV_CH), 0.5),
        "page_table": page_table,
        "c_prompt": nrm(ks[6], (BATCH, D_MODEL), 1.0),
        "c_sample": nrm(ks[7], (DEC_BATCH, D_MODEL), 1.0),
        "norm_mix_g": 1.0 + nrm(ks[8], (DEPTH, D_MODEL), 0.05),
        "norm_ffn_g": 1.0 + nrm(ks[9], (DEPTH, D_MODEL), 0.05),
        "norm_final_g": 1.0 + nrm(ks[10], (D_MODEL,), 0.05),
        "w_ada": nrm(ks[11], (DEPTH, D_MODEL, 6 * D_MODEL), 0.5 * D_MODEL ** -0.5),
        "b_ada": nrm(ks[12], (DEPTH, 6 * D_MODEL), 0.02),
        "w_in": nrm(ks[13], (DEPTH, D_MODEL, IN_WIDTH), D_MODEL ** -0.5),
        "conv_dw_w": nrm(ks[14], (DEPTH, CONV_WIDTH, CONV_CH), CONV_WIDTH ** -0.5),
        "conv_dw_b": nrm(ks[15], (DEPTH, CONV_CH), 0.02),
        "conv_ln_g": 1.0 + nrm(ks[16], (DEPTH, CONV_CH), 0.05),
        "conv_ln_b": nrm(ks[17], (DEPTH, CONV_CH), 0.02),
        "lambda_q1": nrm(ks[18], (DEPTH, HEAD_DIM), 0.1),
        "lambda_k1": nrm(ks[19], (DEPTH, HEAD_DIM), 0.1),
        "lambda_q2": nrm(ks[20], (DEPTH, HEAD_DIM), 0.1),
        "lambda_k2": nrm(ks[21], (DEPTH, HEAD_DIM), 0.1),
        "subln_g": 1.0 + nrm(ks[22], (DEPTH, V_DIM), 0.05),
        "w_out": nrm(ks[23], (DEPTH, MIX_WIDTH, D_MODEL), MIX_WIDTH ** -0.5),
        "w_ffn_in": nrm(ks[24], (DEPTH, D_MODEL, 2 * D_FF), D_MODEL ** -0.5),
        "w_ffn_out": nrm(ks[25], (DEPTH, D_FF, D_MODEL), D_FF ** -0.5),
    }


def reference(x_prompt, x_sample, cache_k, cache_v, state_conv, page_table, c_prompt, c_sample,
              norm_mix_g, norm_ffn_g, norm_final_g, w_ada, b_ada, w_in, conv_dw_w, conv_dw_b,
              conv_ln_g, conv_ln_b, lambda_q1, lambda_k1, lambda_q2, lambda_k2, subln_g,
              w_out, w_ffn_in, w_ffn_out):
    B, S, _ = x_prompt.shape
    DB, T, _ = x_sample.shape
    n_pages = page_table.shape[1]
    past = n_pages * cache_k.shape[2]
    pos_p = jnp.arange(S, dtype=jnp.int32)
    pos_s = past + jnp.arange(T, dtype=jnp.int32)
    kpos_s = jnp.arange(past + T, dtype=jnp.int32)
    conv_zero = jnp.zeros((B, CONV_WIDTH - 1, CONV_CH), x_prompt.dtype)

    xp, xs = x_prompt, x_sample
    kp_l, vp_l, cp_l, ks_l, vs_l, cs_l = [], [], [], [], [], []
    for l in range(DEPTH):
        lam_init = lambda_init_for(l)
        w = (norm_mix_g[l], norm_ffn_g[l], w_ada[l], b_ada[l], w_in[l], conv_dw_w[l], conv_dw_b[l],
             conv_ln_g[l], conv_ln_b[l], lambda_q1[l], lambda_k1[l], lambda_q2[l], lambda_k2[l],
             subln_g[l], w_out[l], w_ffn_in[l], w_ffn_out[l])
        k_past = cache_k[l][page_table].reshape(DB, past, N_HEADS, K_DIM)
        v_past = cache_v[l][page_table].reshape(DB, past, N_HEADS, V_DIM)
        xp, kp, vp, cp = hybrid_layer(xp, c_prompt, conv_zero, None, None, pos_p, pos_p, lam_init, True, *w)
        xs, ksn, vsn, csn = hybrid_layer(xs, c_sample, state_conv[l], k_past, v_past, pos_s, kpos_s,
                                         lam_init, False, *w)
        kp_l.append(kp); vp_l.append(vp); cp_l.append(cp)
        ks_l.append(ksn); vs_l.append(vsn); cs_l.append(csn)

    y_prompt = rmsnorm(xp, norm_final_g)
    y_sample = rmsnorm(xs, norm_final_g)
    k_prompt = jnp.stack(kp_l)
    v_prompt = jnp.stack(vp_l)
    conv_prompt = jnp.stack(cp_l)
    k_sample = jnp.stack(ks_l)
    v_sample = jnp.stack(vs_l)
    conv_sample = jnp.stack(cs_l)
    return (y_prompt, y_sample, k_prompt, v_prompt, conv_prompt, k_sample, v_sample, conv_sample)
```

```cpp
#include <hip/hip_runtime.h>
#include <hip/hip_bf16.h>
#include <cstdio>
#include <cstdint>
#include <cmath>
constexpr int DM = 1024, SEQ = 8192, MP = 16384, DB = 128, MR = MP + DB, MPAD = 16640;
constexpr int CCH = 512, CWID = 31, IN_W = 2560, DFF = 2816, NMOD = 6144, NPAGE = 16, PAGE = 128, PAST = 2048;
constexpr int MOD_SH_M = 0, MOD_SC_M = 1024, MOD_GT_M = 2048, MOD_SH_F = 3072, MOD_SC_F = 4096, MOD_GT_F = 5120;
constexpr int OFF_Y = 0, OFF_KP = 16908288, OFF_VP = 25296896, OFF_CP = 33685504, OFF_KS = 33716224, OFF_VS = 33781760, OFF_CS = 33847296, OUT_TOTAL = 35813376;
constexpr float QSCALE = 0.125f * 1.4426950408889634f;
constexpr float NORM_EPS = 1e-6f, LAM_INIT = 0.2f;
namespace pg8 {
#define PG8_LAS __attribute__((address_space(3)))
typedef unsigned short bf16_t;
typedef short bf16x8 __attribute__((ext_vector_type(8)));
typedef float f32x4 __attribute__((ext_vector_type(4)));
typedef unsigned u32x4 __attribute__((ext_vector_type(4)));
constexpr int BM = 256, BK = 64, HALF = 128, HTB = HALF * BK * 2  , STAGE_BYTES = 8 * HTB, NXCD = 8, WGM = 8;

__host__ __device__ __forceinline__ int lds_byte(int r, int c) { const int st = (r >> 4) * 2 + (c >> 5), rr = r & 15, cc = c & 31, ob = rr * 64 + cc * 2; return st * 1024 + (ob ^ (((ob >> 9) & 1) << 5)); }
__host__ __device__ __forceinline__ void stage_rc(int b, int& R, int& C) { const int st = b / 1024, sb = b % 1024, swz = sb ^ (((sb >> 9) & 1) << 5); R = (st >> 1) * 16 + swz / 64; C = (st & 1) * 32 + (swz % 64) / 2; }
__host__ __device__ __forceinline__ int perm32(int rho) { const int n = rho >> 4, i = rho & 15; return 8 * (i >> 2) + 4 * n + (i & 3); }

struct Unit { int pm, pn; };
struct Gemm { const bf16_t* A; const bf16_t* Bt; int M, N, K; };

struct StaticOrder {
    int nM, nN, nwg, G, c;
    __host__ __device__ void init(int M, int N, int G_, int c_) { nM = M / BM; nN = N / BM; nwg = nM * nN; G = G_; c = c_; }
    __host__ __device__ bool next(int i, Unit& u) const {
        const long L = (long)i * G + c; if (L >= nwg) return false;
        int wgid = (int)L; { const int q = nwg / NXCD, r = nwg % NXCD, xcd = wgid % NXCD, off = wgid / NXCD; wgid = (xcd < r ? xcd * (q + 1) : r * (q + 1) + (xcd - r) * q) + off; }
        const int nig = WGM * nN, gid = wgid / nig, fm = gid * WGM, gsz = (nM - fm) < WGM ? (nM - fm) : WGM;
        u.pm = fm + ((wgid % nig) % gsz); u.pn = (wgid % nig) / gsz; return true;
    }
    __device__ __forceinline__ void a_ready(const Unit&) const {}
    __device__ __forceinline__ void done(const Unit&) const {}
};

__device__ __forceinline__ unsigned cvt_pk_bf16(float lo, float hi) { unsigned r; asm volatile("v_cvt_pk_bf16_f32 %0, %1, %2" : "=v"(r) : "v"(lo), "v"(hi)); return r; }
typedef float f32x2 __attribute__((ext_vector_type(2)));
__device__ __forceinline__ float sigm(float x) { return __builtin_amdgcn_rcpf(1.0f + __expf(-x)); }
__device__ __forceinline__ u32x4 pack8(const f32x4& a, const f32x4& b) { u32x4 w; w.x = cvt_pk_bf16(a[0], a[1]); w.y = cvt_pk_bf16(a[2], a[3]); w.z = cvt_pk_bf16(b[0], b[1]); w.w = cvt_pk_bf16(b[2], b[3]); return w; }
struct EpiIn {
    static constexpr bool PERM = true, AFTER_DRAIN = false;
    bf16_t *U, *Q, *K, *V; float* out; const float* rope;
    __device__ __forceinline__ void operator()(const f32x4 (&acc)[2][2][4][2], const Unit& u, int wr, int wc, int fr, int fq) const {
        const int row0 = u.pm * BM + wr * 64 + fr, cw = wc * 32 + 8 * fq;
        if (u.pn < 4) {
#pragma unroll
            for (int ai = 0; ai < 2; ++ai) {
#pragma unroll
                for (int m = 0; m < 4; ++m) { const int row = row0 + ai * HALF + m * 16;
                    f32x4 a0 = acc[ai][0][m][0], a1 = acc[ai][0][m][1]; const f32x4 g0 = acc[ai][1][m][0], g1 = acc[ai][1][m][1];
#pragma unroll
                    for (int i = 0; i < 4; ++i) { a0[i] *= sigm(g0[i]); a1[i] *= sigm(g1[i]); }
                    *(u32x4*)(U + (size_t)row * CCH + u.pn * 128 + cw) = pack8(a0, a1);
 } }
        } else if (u.pn < 8) {
            const bool isq = u.pn < 6, rot = (wc & 1) == 0; const int cb = ((u.pn - 4) & 1) * 256 + cw;
#pragma unroll
            for (int ai = 0; ai < 2; ++ai) {
#pragma unroll
                for (int m = 0; m < 4; ++m) { const int row = row0 + ai * HALF + m * 16, pos = row & (SEQ - 1);
                    f32x4 c0 = {1.f, 1.f, 1.f, 1.f}, c1 = c0, s0 = {0.f, 0.f, 0.f, 0.f}, s1 = s0;
                    if (rot && fq < 2) { const float* rp = rope + pos * 16; c0 = *(const f32x4*)rp; c1 = *(const f32x4*)(rp + 4); s0 = *(const f32x4*)(rp + 8); s1 = *(const f32x4*)(rp + 12);
                        if (fq == 0) { s0 = -s0; s1 = -s1; } }
#pragma unroll
                    for (int bj = 0; bj < 2; ++bj) { f32x4 v0 = acc[ai][bj][m][0], v1 = acc[ai][bj][m][1];
                        if (rot) { f32x4 p0, p1;
#pragma unroll
                            for (int i = 0; i < 4; ++i) { p0[i] = __shfl_xor(v0[i], 16); p1[i] = __shfl_xor(v1[i], 16); }
                            v0 = v0 * c0 + p0 * s0; v1 = v1 * c1 + p1 * s1; }
                        const int col = cb + bj * HALF;
                        if (isq) { v0 = v0 * QSCALE; v1 = v1 * QSCALE; *(u32x4*)(Q + (size_t)row * CCH + col) = pack8(v0, v1); }
                        else { *(u32x4*)(K + (size_t)row * CCH + col) = pack8(v0, v1);
                            float* ko = out + OFF_KP + (size_t)row * CCH + col; *(f32x4*)ko = v0; *(f32x4*)(ko + 4) = v1; } } } }
        } else {
            const int cb = (u.pn - 8) * 256 + cw;
#pragma unroll
            for (int ai = 0; ai < 2; ++ai) {
#pragma unroll
                for (int m = 0; m < 4; ++m) { const int row = row0 + ai * HALF + m * 16;
#pragma unroll
                    for (int bj = 0; bj < 2; ++bj) { const f32x4 v0 = acc[ai][bj][m][0], v1 = acc[ai][bj][m][1]; const int col = cb + bj * HALF;
                        *(u32x4*)(V + (size_t)row * CCH + col) = pack8(v0, v1);
                        float* vo = out + OFF_VP + (size_t)row * CCH + col; *(f32x4*)vo = v0; *(f32x4*)(vo + 4) = v1; } } }
        }
    }
};
struct EpiRes {
    static constexpr bool PERM = false, AFTER_DRAIN = false;
    const float* bp; const float* gate; float* dst;
    __device__ __forceinline__ void operator()(const f32x4 (&acc)[2][2][4][2], const Unit& u, int wr, int wc, int fr, int fq) const {
        const int row0 = u.pm * BM + wr * 64 + fr, col0 = u.pn * BM + wc * 32 + 4 * fq;
#pragma unroll
        for (int ai = 0; ai < 2; ++ai) {
#pragma unroll
            for (int m = 0; m < 4; ++m) { const int row = row0 + ai * HALF + m * 16;
                const float* br = bp + (size_t)row * DM; const float* gr = gate + (size_t)(row >> 13) * NMOD;
#pragma unroll
                for (int bj = 0; bj < 2; ++bj)
#pragma unroll
                    for (int n = 0; n < 2; ++n) { const int col = col0 + bj * HALF + n * 16;
                        *(f32x4*)(dst + (size_t)row * DM + col) = *(const f32x4*)(br + col) + *(const f32x4*)(gr + col) * acc[ai][bj][m][n]; } } }
    }
};
struct EpiSwiglu {
    static constexpr bool PERM = true, AFTER_DRAIN = false;
    bf16_t* ACT;
    __device__ __forceinline__ void operator()(const f32x4 (&acc)[2][2][4][2], const Unit& u, int wr, int wc, int fr, int fq) const {
        const int row0 = u.pm * BM + wr * 64 + fr, col = u.pn * 128 + wc * 32 + 8 * fq;
#pragma unroll
        for (int ai = 0; ai < 2; ++ai) {
#pragma unroll
            for (int m = 0; m < 4; ++m) { const int row = row0 + ai * HALF + m * 16;
                f32x4 g0 = acc[ai][0][m][0], g1 = acc[ai][0][m][1]; const f32x4 u0 = acc[ai][1][m][0], u1 = acc[ai][1][m][1];
#pragma unroll
                for (int i = 0; i < 4; ++i) { g0[i] = g0[i] * sigm(g0[i]) * u0[i]; g1[i] = g1[i] * sigm(g1[i]) * u1[i]; }
                *(u32x4*)(ACT + (size_t)row * DFF + col) = pack8(g0, g1); } }
    }
};
template <class Epi, class Sched, bool ALIGN_EPI = false, bool SP2 = false>
__device__ __forceinline__ void gemm_phase(PG8_LAS unsigned char* lds, const Gemm g, const Sched& S, const Epi& E) {
    const int tid = threadIdx.x, wid = __builtin_amdgcn_readfirstlane(tid >> 6), lane = tid & 63, wr = wid >> 2, wc = wid & 3, fr = lane & 15, fq = lane >> 4;
    const int K = g.K, nt = K / BK;
    unsigned voffA[2], voffB[2];
#pragma unroll
    for (int i = 0; i < 2; ++i) { int R, C; stage_rc(tid * 16 + i * 8192, R, C); const int Rb = Epi::PERM ? ((R & ~31) + perm32(R & 31)) : R;
        voffA[i] = (unsigned)(R * K + C) * 2u; voffB[i] = (unsigned)(Rb * K + C) * 2u; }
    const size_t kstep = (size_t)(BK * 2);
    const size_t hstep = (size_t)HALF * K * 2;
    const size_t tstep = 2 * hstep;
    const unsigned ldsw = (unsigned)wid * 1024u;
    const int aoff = lds_byte(wr * 64 + fr, fq * 8), boff = lds_byte(wc * 32 + fr, fq * 8);
#define PG8_SA(b, h) (((b) * 2 + (h)) * HTB)
#define PG8_SB(b, h) ((4 + (b) * 2 + (h)) * HTB)
#define PG8_STAGE(bufoff, gbase, voff) do { _Pragma("unroll") for (int _i = 0; _i < 2; ++_i) \
        __builtin_amdgcn_global_load_lds((const unsigned*)((const char*)(gbase) + (voff)[_i]), (PG8_LAS unsigned*)(lds + (bufoff) + ldsw + _i * 8192), 16, 0, 0); } while (0)
#define PG8_LDA(dst, b, h) do { _Pragma("unroll") for (int m = 0; m < 4; ++m) _Pragma("unroll") for (int k = 0; k < 2; ++k) dst[m][k] = *(const PG8_LAS bf16x8*)(lds + PG8_SA(b, h) + aoff + m * 2048 + k * 1024); } while (0)
#define PG8_LDB(dst, b, h) do { _Pragma("unroll") for (int n = 0; n < 2; ++n) _Pragma("unroll") for (int k = 0; k < 2; ++k) dst[n][k] = *(const PG8_LAS bf16x8*)(lds + PG8_SB(b, h) + boff + n * 2048 + k * 1024); } while (0)
#define PG8_MMA(ai, bj, At, Bt) do { __builtin_amdgcn_s_setprio(1); _Pragma("unroll") for (int m = 0; m < 4; ++m) _Pragma("unroll") for (int n = 0; n < 2; ++n) _Pragma("unroll") for (int k = 0; k < 2; ++k) \
        acc[ai][bj][m][n] = __builtin_amdgcn_mfma_f32_16x16x32_bf16(Bt[n][k], At[m][k], acc[ai][bj][m][n], 0, 0, 0); __builtin_amdgcn_s_setprio(0); } while (0)
#define PG8_WAIT_V(n) asm volatile("s_waitcnt vmcnt(" #n ")" ::: "memory")
#define PG8_WAIT_L(n) asm volatile("s_waitcnt lgkmcnt(" #n ")" ::: "memory")
#define PG8_BAR __builtin_amdgcn_s_barrier()
#define PG8_SCHED __builtin_amdgcn_sched_barrier(0)
    Unit cur, nxt; int ui = 0;
    if (!S.next(0, cur)) return;
    f32x4 acc[2][2][4][2];
#pragma unroll
    for (int a = 0; a < 2; ++a)
#pragma unroll
        for (int b = 0; b < 2; ++b)
#pragma unroll
            for (int m = 0; m < 4; ++m)
#pragma unroll
                for (int n = 0; n < 2; ++n) acc[a][b][m][n] = (f32x4){0.f, 0.f, 0.f, 0.f};
    bf16x8 At[4][2], B0[2][2], B1[2][2];
    const char* cA = (const char*)g.A + (size_t)cur.pm * tstep; const char* cB = (const char*)g.Bt + (size_t)cur.pn * tstep;
    S.a_ready(cur);
    if constexpr (SP2) {
        PG8_STAGE(PG8_SB(0, 0), cB, voffB); PG8_STAGE(PG8_SB(0, 1), cB + hstep, voffB); PG8_STAGE(PG8_SA(0, 0), cA, voffA); PG8_STAGE(PG8_SA(0, 1), cA + hstep, voffA);
        if (wr == 1) PG8_BAR;
        PG8_WAIT_V(2); PG8_BAR;
        PG8_STAGE(PG8_SB(1, 0), cB + kstep, voffB); PG8_STAGE(PG8_SA(1, 0), cA + kstep, voffA); PG8_STAGE(PG8_SB(1, 1), cB + hstep + kstep, voffB);
        PG8_WAIT_V(6); PG8_BAR;
    } else {
        PG8_STAGE(PG8_SB(0, 0), cB, voffB); PG8_STAGE(PG8_SA(0, 0), cA, voffA); PG8_STAGE(PG8_SB(0, 1), cB + hstep, voffB); PG8_STAGE(PG8_SA(0, 1), cA + hstep, voffA);
        if (wr == 1) PG8_BAR;
        PG8_WAIT_V(4); PG8_BAR;
        PG8_STAGE(PG8_SB(1, 0), cB + kstep, voffB); PG8_STAGE(PG8_SA(1, 0), cA + kstep, voffA); PG8_STAGE(PG8_SB(1, 1), cB + hstep + kstep, voffB);
        PG8_WAIT_V(6); PG8_BAR;
    }
    for (;;) {
        const bool has_next = S.next(ui + 1, nxt);
        const char* nA = has_next ? (const char*)g.A + (size_t)nxt.pm * tstep : cA; const char* nB = has_next ? (const char*)g.Bt + (size_t)nxt.pn * tstep : cB;
        for (int t = 0; t < nt; t += 2) {
            const bool last = (t == nt - 2);
            const char* a1 = cA + (size_t)(t + 1) * kstep;
            const char* a2 = last ? nA : cA + (size_t)(t + 2) * kstep; const char* b2 = last ? nB : cB + (size_t)(t + 2) * kstep;
            const char* a3 = a2 + kstep; const char* b3 = b2 + kstep;
            if (last && has_next) S.a_ready(nxt);
            if constexpr (SP2) {
            PG8_LDB(B0, 0, 0); PG8_LDB(B1, 0, 1); PG8_SCHED; PG8_LDA(At, 0, 0); PG8_STAGE(PG8_SA(1, 1), a1 + hstep, voffA);
            PG8_WAIT_V(8); PG8_WAIT_L(0); PG8_BAR; PG8_MMA(0, 0, At, B0); PG8_MMA(0, 1, At, B1); PG8_BAR; PG8_SCHED;
            PG8_LDA(At, 0, 1); PG8_STAGE(PG8_SB(0, 0), b2, voffB); PG8_STAGE(PG8_SB(0, 1), b2 + hstep, voffB); PG8_STAGE(PG8_SA(0, 0), a2, voffA);
            PG8_WAIT_V(8); PG8_WAIT_L(0); PG8_BAR; PG8_MMA(1, 0, At, B0); PG8_MMA(1, 1, At, B1); PG8_BAR; PG8_SCHED;
            PG8_LDB(B0, 1, 0); PG8_LDB(B1, 1, 1); PG8_SCHED; PG8_LDA(At, 1, 0); PG8_STAGE(PG8_SA(0, 1), a2 + hstep, voffA);
            PG8_WAIT_V(8); PG8_WAIT_L(0); PG8_BAR; PG8_MMA(0, 0, At, B0); PG8_MMA(0, 1, At, B1); PG8_BAR; PG8_SCHED;
            PG8_LDA(At, 1, 1); PG8_STAGE(PG8_SB(1, 0), b3, voffB); PG8_STAGE(PG8_SB(1, 1), b3 + hstep, voffB); PG8_STAGE(PG8_SA(1, 0), a3, voffA);
            PG8_WAIT_V(8); PG8_WAIT_L(0); PG8_BAR; PG8_MMA(1, 0, At, B0); PG8_MMA(1, 1, At, B1); PG8_BAR; PG8_SCHED;
            } else {
            PG8_LDB(B0, 0, 0); PG8_SCHED; PG8_LDA(At, 0, 0); PG8_STAGE(PG8_SA(1, 1), a1 + hstep, voffA);
            PG8_WAIT_L(8); PG8_BAR; PG8_WAIT_L(0); PG8_MMA(0, 0, At, B0); PG8_BAR; PG8_SCHED;
            PG8_LDB(B1, 0, 1); PG8_STAGE(PG8_SB(0, 0), b2, voffB);
            PG8_BAR; PG8_WAIT_L(0); PG8_MMA(0, 1, At, B1); PG8_BAR;
            PG8_LDA(At, 0, 1); PG8_STAGE(PG8_SA(0, 0), a2, voffA);
            PG8_BAR; PG8_WAIT_L(0); PG8_MMA(1, 0, At, B0); PG8_BAR; PG8_SCHED;
            PG8_STAGE(PG8_SB(0, 1), b2 + hstep, voffB);
            PG8_WAIT_V(6); PG8_BAR; PG8_MMA(1, 1, At, B1); PG8_BAR;
            PG8_LDB(B0, 1, 0); PG8_SCHED; PG8_LDA(At, 1, 0); PG8_STAGE(PG8_SA(0, 1), a2 + hstep, voffA);
            PG8_WAIT_L(8); PG8_BAR; PG8_WAIT_L(0); PG8_MMA(0, 0, At, B0); PG8_BAR; PG8_SCHED;
            PG8_LDB(B1, 1, 1); PG8_STAGE(PG8_SB(1, 0), b3, voffB);
            PG8_BAR; PG8_WAIT_L(0); PG8_MMA(0, 1, At, B1); PG8_BAR;
            PG8_LDA(At, 1, 1); PG8_STAGE(PG8_SA(1, 0), a3, voffA);
            PG8_BAR; PG8_WAIT_L(0); PG8_MMA(1, 0, At, B0); PG8_BAR; PG8_SCHED;
            PG8_STAGE(PG8_SB(1, 1), b3 + hstep, voffB);
            PG8_WAIT_V(6); PG8_BAR; PG8_MMA(1, 1, At, B1); PG8_BAR;
            }
        }
        if constexpr (ALIGN_EPI) { if (wr == 0) PG8_BAR; }
        if constexpr (!Epi::AFTER_DRAIN) { E(acc, cur, wr, wc, fr, fq); S.done(cur); }
        if (!has_next) break;
#pragma unroll
        for (int a = 0; a < 2; ++a)
#pragma unroll
            for (int b = 0; b < 2; ++b)
#pragma unroll
                for (int m = 0; m < 4; ++m)
#pragma unroll
                    for (int n = 0; n < 2; ++n) acc[a][b][m][n] = (f32x4){0.f, 0.f, 0.f, 0.f};
        cur = nxt; cA = nA; cB = nB; ++ui;
        if constexpr (ALIGN_EPI) { if (wr == 1) PG8_BAR; }
    }
    PG8_WAIT_V(0);
    if constexpr (!ALIGN_EPI) { if (wr == 0) PG8_BAR; }
    PG8_BAR;
    if constexpr (Epi::AFTER_DRAIN) { E.fused(acc, cur, wr, wc, fr, fq, lds, wid, lane); S.done(cur); }
#undef PG8_SA
#undef PG8_SB
#undef PG8_STAGE
#undef PG8_LDA
#undef PG8_LDB
#undef PG8_MMA
#undef PG8_WAIT_V
#undef PG8_WAIT_L
#undef PG8_BAR
#undef PG8_SCHED
}
}

#ifndef PG8_SP2
#define PG8_SP2 true
#endif
#ifndef PG8_ALIGN
#define PG8_ALIGN true
#endif
#include <hip/hip_bf16.h>
#include <cmath>
namespace attn_body {
using bf16=__hip_bfloat16;
using bf16x8=__attribute__((ext_vector_type(8)))short;
using s16x4=__attribute__((ext_vector_type(4)))short;
using f32x16=__attribute__((ext_vector_type(16)))float;
using u32x4=__attribute__((ext_vector_type(4)))unsigned;
constexpr int BATCH=2,NHEAD=16,SEQ=8192,D=64,PQ=512,PO=1024;
constexpr int NW=8,QBLK=32,QB=QBLK*NW,KVBLK=64,NQB=SEQ/QB;
constexpr int ATTN_UNIT_ROWS=QB;
__device__ __forceinline__ int crow(int r,int hi){return (r&3)+8*(r>>2)+4*hi;}
#define SBAR() __builtin_amdgcn_sched_barrier(0)
__device__ __forceinline__ void cmask(f32x16&p0,f32x16&p1,int jb,int qrel,int hi){
  const float NEG=-INFINITY; int kb=64*jb+4*hi;
  #pragma unroll
  for(int r=0;r<16;++r){int kv=kb+(r&3)+8*(r>>2); if(kv>qrel)p0[r]=NEG; if(kv+32>qrel)p1[r]=NEG;}
}

constexpr int NSLOT=3, SLOTB=8192;
constexpr int LDS_K=0, LDS_V=NSLOT*SLOTB, LDS_WS=2*NSLOT*SLOTB, LDS_OST=LDS_WS+NW*64*4, LDS_BYTES=LDS_OST+NW*4096;
constexpr float C2=0.125f*1.4426950408889634f;
__device__ __forceinline__ void glds16(const void*gsrc,unsigned lds_dst){unsigned keep;
  asm volatile("s_mov_b32 %0, m0\n\ts_mov_b32 m0, %2\n\ts_nop 0\n\tglobal_load_lds_dwordx4 %1, off\n\ts_mov_b32 m0, %0":"=&s"(keep):"v"(gsrc),"s"(lds_dst):"memory");}
__device__ __forceinline__ float max3f(float a,float b,float c){float r;asm("v_max3_f32 %0, %1, %2, %3":"=v"(r):"v"(a),"v"(b),"v"(c));return r;}
__device__ __forceinline__ float max2f(float a,float b){float r;asm("v_max_f32_e32 %0, %1, %2":"=v"(r):"v"(a),"v"(b));return r;}
__device__ __forceinline__ float fadd_s(float a,float b){float r;asm("v_add_f32_e32 %0, %1, %2":"=v"(r):"v"(a),"v"(b));return r;}
__device__ __forceinline__ float fsub_s(float a,float b){float r;asm("v_sub_f32_e32 %0, %1, %2":"=v"(r):"v"(a),"v"(b));return r;}
typedef float f32x2_t __attribute__((ext_vector_type(2))); typedef __bf16 bf16x2_t __attribute__((ext_vector_type(2)));
__device__ __forceinline__ unsigned cvtpk_s(float lo,float hi){f32x2_t v={lo,hi};bf16x2_t b=__builtin_convertvector(v,bf16x2_t);return __builtin_bit_cast(unsigned,b);}
#define WAIT_BAR(N) asm volatile("s_waitcnt vmcnt(" #N ") lgkmcnt(0)\n\ts_barrier":::"memory")

__device__ __forceinline__ void qkt(f32x16&p0,f32x16&p1,const char*Kslot,const bf16x8*qr,const f32x16&negm,int r32,int hi){
  const char*kb=Kslot+hi*1024+r32*16;
  #pragma unroll
  for(int d0=0;d0<4;++d0){
    const bf16x8 b0=*reinterpret_cast<const bf16x8*>(kb+d0*2048);
    const bf16x8 b1=*reinterpret_cast<const bf16x8*>(kb+d0*2048+512);
    if(d0==0){p0=__builtin_amdgcn_mfma_f32_32x32x16_bf16(b0,qr[0],negm,0,0,0);p1=__builtin_amdgcn_mfma_f32_32x32x16_bf16(b1,qr[0],negm,0,0,0);}
    else{p0=__builtin_amdgcn_mfma_f32_32x32x16_bf16(b0,qr[d0],p0,0,0,0);p1=__builtin_amdgcn_mfma_f32_32x32x16_bf16(b1,qr[d0],p1,0,0,0);}}
}
typedef __attribute__((address_space(3))) const char* lds_cptr;
typedef short v4i16_t __attribute__((ext_vector_type(4)));
__device__ __forceinline__ void kload8(bf16x8*kf,lds_cptr kp){
  kf[0]=*(const __attribute__((address_space(3))) bf16x8*)(kp);      kf[1]=*(const __attribute__((address_space(3))) bf16x8*)(kp+512);
  kf[2]=*(const __attribute__((address_space(3))) bf16x8*)(kp+2048); kf[3]=*(const __attribute__((address_space(3))) bf16x8*)(kp+2560);
  kf[4]=*(const __attribute__((address_space(3))) bf16x8*)(kp+4096); kf[5]=*(const __attribute__((address_space(3))) bf16x8*)(kp+4608);
  kf[6]=*(const __attribute__((address_space(3))) bf16x8*)(kp+6144); kf[7]=*(const __attribute__((address_space(3))) bf16x8*)(kp+6656);
}
__device__ __forceinline__ void kload2(bf16x8*kf,lds_cptr kp,int j){ kf[2*j]=*(const __attribute__((address_space(3))) bf16x8*)(kp+j*2048); kf[2*j+1]=*(const __attribute__((address_space(3))) bf16x8*)(kp+j*2048+512); }
__device__ __forceinline__ s16x4 vtr(lds_cptr p){ return __builtin_bit_cast(s16x4,__builtin_amdgcn_ds_read_tr16_b64_v4i16((__attribute__((address_space(3))) v4i16_t*)p)); }
__device__ __forceinline__ float rowmax(const f32x16&p0,const f32x16&p1){
  float a=max3f(p0[0],p0[1],p1[0]),b=max3f(p0[2],p0[3],p1[1]);a=max3f(a,p1[2],p1[3]);
  #pragma unroll
  for(int r=4;r<16;r+=4){a=max3f(a,p0[r],p0[r+1]);b=max3f(b,p0[r+2],p0[r+3]);a=max3f(a,p1[r],p1[r+1]);b=max3f(b,p1[r+2],p1[r+3]);}
  const float m=max2f(a,b);
  auto rr=__builtin_amdgcn_permlane32_swap(__float_as_uint(m),__float_as_uint(m),false,false);
  return max2f(__uint_as_float(rr[0]),__uint_as_float(rr[1]));
}
__device__ __forceinline__ void pv(f32x16*o,int vb,bf16x8 pa0,bf16x8 pa1,bf16x8 pa2,bf16x8 pa3){
  #pragma unroll
  for(int d0=0;d0<2;++d0){s16x4 lo[4],hi[4];
    #pragma unroll
    for(int ks=0;ks<4;++ks){
      asm volatile("ds_read_b64_tr_b16 %0,%1 offset:%c2":"=&v"(lo[ks]):"v"(vb),"i"(d0*4096+ks*1024):"memory");
      asm volatile("ds_read_b64_tr_b16 %0,%1 offset:%c2":"=&v"(hi[ks]):"v"(vb),"i"(d0*4096+ks*1024+512):"memory");}
    asm volatile("s_waitcnt lgkmcnt(0)":::"memory");SBAR();
    #define PK(k) (bf16x8){lo[k][0],lo[k][1],lo[k][2],lo[k][3],hi[k][0],hi[k][1],hi[k][2],hi[k][3]}
    o[d0]=__builtin_amdgcn_mfma_f32_32x32x16_bf16(pa0,PK(0),o[d0],0,0,0);
    o[d0]=__builtin_amdgcn_mfma_f32_32x32x16_bf16(pa1,PK(1),o[d0],0,0,0);
    o[d0]=__builtin_amdgcn_mfma_f32_32x32x16_bf16(pa2,PK(2),o[d0],0,0,0);
    o[d0]=__builtin_amdgcn_mfma_f32_32x32x16_bf16(pa3,PK(3),o[d0],0,0,0);
    #undef PK
  }
}

#ifndef ATTN_STORE16
#define ATTN_STORE16(p,v) (*(u32x4*)(p)=(v))
#endif
template<int THRL> __device__ __forceinline__ void attn_unit(int b,int qcol,int kcol,int vcol,int ocol,int qb,const bf16*Q,const bf16*__restrict__ K,const bf16*__restrict__ V,bf16*O,char*shm){
  const int tid=threadIdx.x,lane=tid&63,r32=lane&31,hi=lane>>5; const int wid=__builtin_amdgcn_readfirstlane(tid>>6);
  const long rowbase=(long)b*SEQ; const int q0=qb*QB;
  const bf16*Qw=Q+(rowbase+q0+wid*QBLK)*PQ+qcol;
  const bf16*Kh=K+rowbase*PQ+kcol,*Vh=V+rowbase*PQ+vcol;
  const unsigned lds0=(unsigned)(uintptr_t)shm;
  float*wsf=(float*)(shm+LDS_WS)+wid*64;
  const bf16*ksrc=Kh+(long)lane*PQ+wid*8;
  const bf16*vsrc=Vh+(long)(16*(wid&3)+(lane>>2))*PQ+(wid>>2)*32+(lane&3)*8;
  const unsigned kdst=lds0+LDS_K+wid*1024, vdst=lds0+LDS_V+wid*1024;
  #define DMA_K(t,slot) glds16(ksrc+(long)(t)*KVBLK*PQ,(unsigned)__builtin_amdgcn_readfirstlane(kdst+(slot)))
  #define DMA_V(t,slot) glds16(vsrc+(long)(t)*KVBLK*PQ,(unsigned)__builtin_amdgcn_readfirstlane(vdst+(slot)))
  const int vb0=(int)(lds0+LDS_V)+((lane>>4)&1)*32+(lane&3)*8+(4*hi+((lane&15)>>2))*64;
  const char*Kbase=shm+LDS_K; bf16x8 kf[8];
  const lds_cptr shm3=(lds_cptr)shm; const lds_cptr kp0=shm3+LDS_K+hi*1024+r32*16; const lds_cptr vp0=shm3+LDS_V+((lane>>4)&1)*32+(lane&3)*8+(4*hi+((lane&15)>>2))*64;
  const int NT=(q0+QB)/KVBLK;
  DMA_K(0,0);DMA_V(0,0);DMA_K(1,SLOTB);
  bf16x8 qr[4];
  #pragma unroll
  for(int d0=0;d0<4;++d0)qr[d0]=*reinterpret_cast<const bf16x8*>(&Qw[(long)r32*PQ+d0*16+hi*8]);
  float mhat=0.f,l_reg=0.f;f32x16 o[2];o[0]=f32x16{};o[1]=f32x16{};f32x16 negm=f32x16{};asm volatile("":"+v"(negm));
  const int qrel=wid*QBLK+r32;
  #define CMASK(P0,P1,t) do{int jb_=(t)-(NT-4); if(jb_>=0)cmask(P0,P1,jb_,qrel,hi);}while(0)
  bool resc=false;
  #define START(P0,P1) do{ const float rm=rowmax(P0,P1); resc=false; \
    { const float dl=rm; mhat=fadd_s(mhat,dl); \
      _Pragma("unroll") for(int r=0;r<16;++r){P0[r]=fsub_s(P0[r],dl);P1[r]=fsub_s(P1[r],dl);} \
      _Pragma("unroll") for(int r=0;r<16;++r)negm[r]=-mhat; asm volatile("":"+v"(negm)); } \
    _Pragma("unroll") for(int r=0;r<16;++r)P0[r]=__builtin_amdgcn_exp2f(P0[r]); }while(0)
  #define RESC() do{ if(resc){ asm volatile("s_waitcnt lgkmcnt(0)":::"memory"); \
      _Pragma("unroll") for(int d_=0;d_<2;++d_) _Pragma("unroll") for(int r=0;r<16;++r)o[d_][r]*=wsf[crow(r,hi)]; } }while(0)
  f32x16 pA0,pA1,pB0,pB1;
  int sl_prev=0,sl_cur=0,sl_next=SLOTB;
  #define ROT() do{sl_prev=sl_cur;sl_cur=sl_next;sl_next=(sl_next==(NSLOT-1)*SLOTB)?0:sl_next+SLOTB;}while(0)
  DMA_K(2,2*SLOTB);
  WAIT_BAR(3);
  qkt(pA0,pA1,Kbase,qr,negm,r32,hi);asm volatile("s_nop 15\n\ts_nop 7":"+v"(pA0),"+v"(pA1));CMASK(pA0,pA1,0);
  START(pA0,pA1);
  _Pragma("unroll") for(int r=0;r<16;++r)pA1[r]=__builtin_amdgcn_exp2f(pA1[r]);
  WAIT_BAR(0);
  DMA_K(3,0);DMA_V(1,SLOTB);
  ROT();
  kload8(kf,kp0+sl_cur);
  WAIT_BAR(2);
  s16x4 vlo[8],vhi[8]; u32x4 pw0,pw1,pw2,pw3;
  #define PKW(P,B) cvtpk_s(P[B],P[B+1])
  #define PAF(k) __builtin_bit_cast(bf16x8,pw##k)
  #define VFR(i) (bf16x8){vlo[i][0],vlo[i][1],vlo[i][2],vlo[i][3],vhi[i][0],vhi[i][1],vhi[i][2],vhi[i][3]}
  #define PIN(x) asm volatile("":"+v"(x))
  #define MX3(a,b,c) __builtin_fmaxf(__builtin_fmaxf((a),(b)),(c))
  #define GAPA(MF,A0,A1,A2,A3,W0,W1,PW) do{ MF; sacc+=A0; sacc+=A1; sacc+=A2; sacc+=A3; PIN(sacc); W0; W1; PIN(PW); SBAR(); }while(0)
  #define EX(v) __builtin_amdgcn_exp2f(v)
  #define GAPB(MF,X,B) do{ MF; X[B]=EX(X[B]); X[B+1]=EX(X[B+1]); X[B+2]=EX(X[B+2]); X[B+3]=EX(X[B+3]); PIN(X); SBAR(); }while(0)
  #define VRD(i) do{ vlo[i]=vtr(vp_+(((i)>>2)*4096+((i)&3)*1024)); vhi[i]=vtr(vp_+(((i)>>2)*4096+((i)&3)*1024+512)); }while(0)
  #define KRD(G,j) do{ if(G){ kload2(kf,kp0+sl_next,j); SBAR(); } }while(0)
  #define STEP(C0,C1,P0,P1,t,GK,GV,GL) do{ SBAR(); \
    const lds_cptr vp_=vp0+sl_prev; \
    VRD(0); SBAR(); float sacc=(P0[0]+P0[1]); \
    GAPA(C0=__builtin_amdgcn_mfma_f32_32x32x16_bf16(kf[0],qr[0],negm,0,0,0), P0[2],P0[3],P0[4],P0[5],     pw0[0]=PKW(P0,0), pw0[1]=PKW(P0,2), pw0); \
    VRD(4); SBAR(); GAPA(C1=__builtin_amdgcn_mfma_f32_32x32x16_bf16(kf[1],qr[0],negm,0,0,0), P0[6],P0[7],P0[8],P0[9],     pw0[2]=PKW(P0,4), pw0[3]=PKW(P0,6), pw0); \
    VRD(1); SBAR(); GAPA(C0=__builtin_amdgcn_mfma_f32_32x32x16_bf16(kf[2],qr[1],C0,0,0,0),   P0[10],P0[11],P0[12],P0[13], pw1[0]=PKW(P0,8), pw1[1]=PKW(P0,10), pw1); \
    VRD(5); SBAR(); GAPA(C1=__builtin_amdgcn_mfma_f32_32x32x16_bf16(kf[3],qr[1],C1,0,0,0),   P0[14],P0[15],P1[0],P1[1],   pw1[2]=PKW(P0,12),pw1[3]=PKW(P0,14), pw1); \
    VRD(2); SBAR(); GAPA(C0=__builtin_amdgcn_mfma_f32_32x32x16_bf16(kf[4],qr[2],C0,0,0,0),   P1[2],P1[3],P1[4],P1[5],     pw2[0]=PKW(P1,0), pw2[1]=PKW(P1,2), pw2); \
    VRD(6); SBAR(); GAPA(C1=__builtin_amdgcn_mfma_f32_32x32x16_bf16(kf[5],qr[2],C1,0,0,0),   P1[6],P1[7],P1[8],P1[9],     pw2[2]=PKW(P1,4), pw2[3]=PKW(P1,6), pw2); \
    VRD(3); SBAR(); GAPA(C0=__builtin_amdgcn_mfma_f32_32x32x16_bf16(kf[6],qr[3],C0,0,0,0),   P1[10],P1[11],P1[12],P1[13], pw3[0]=PKW(P1,8), pw3[1]=PKW(P1,10), pw3); \
    VRD(7); SBAR(); GAPA(C1=__builtin_amdgcn_mfma_f32_32x32x16_bf16(kf[7],qr[3],C1,0,0,0),   P1[14],P1[15],0.f,0.f,       pw3[2]=PKW(P1,12),pw3[3]=PKW(P1,14), pw3); \
    l_reg+=sacc; \
    if(GK){DMA_K((t)+3,sl_cur);} if(GV){DMA_V((t)+1,sl_next);} \
    CMASK(C0,C1,t); \
    { float a=MX3(C0[0],C0[1],C1[0]),b=MX3(C0[2],C0[3],C1[1]); a=MX3(a,C1[2],C1[3]); \
      _Pragma("unroll") for(int r=4;r<16;r+=4){a=MX3(a,C0[r],C0[r+1]);b=MX3(b,C0[r+2],C0[r+3]);a=MX3(a,C1[r],C1[r+1]);b=MX3(b,C1[r+2],C1[r+3]);} \
      float rm=__builtin_fmaxf(a,b); { auto rr=__builtin_amdgcn_permlane32_swap(__float_as_uint(rm),__float_as_uint(rm),false,false); rm=__builtin_fmaxf(__uint_as_float(rr[0]),__uint_as_float(rr[1])); } \
      resc=false; \
      if(__builtin_expect(__any(rm>(float)THRL),0)){ const float dl=__builtin_fmaxf(rm,0.f); mhat+=dl; \
        _Pragma("unroll") for(int r=0;r<16;++r){C0[r]-=dl;C1[r]-=dl;} \
        _Pragma("unroll") for(int r=0;r<16;++r)negm[r]=-mhat; asm volatile("":"+v"(negm)); \
        const float f=__builtin_amdgcn_exp2f(-dl); l_reg*=f; if(hi==0)wsf[r32]=f; resc=true; } } \
    SBAR(); \
    GAPB(o[0]=__builtin_amdgcn_mfma_f32_32x32x16_bf16(PAF(0),VFR(0),o[0],0,0,0), C0,0); \
    GAPB(o[1]=__builtin_amdgcn_mfma_f32_32x32x16_bf16(PAF(0),VFR(4),o[1],0,0,0), C0,4); \
    KRD(GL,0); GAPB(o[0]=__builtin_amdgcn_mfma_f32_32x32x16_bf16(PAF(1),VFR(1),o[0],0,0,0), C0,8); \
    KRD(GL,1); GAPB(o[1]=__builtin_amdgcn_mfma_f32_32x32x16_bf16(PAF(1),VFR(5),o[1],0,0,0), C0,12); \
    KRD(GL,2); GAPB(o[0]=__builtin_amdgcn_mfma_f32_32x32x16_bf16(PAF(2),VFR(2),o[0],0,0,0), C1,0); \
    KRD(GL,3); GAPB(o[1]=__builtin_amdgcn_mfma_f32_32x32x16_bf16(PAF(2),VFR(6),o[1],0,0,0), C1,4); \
    GAPB(o[0]=__builtin_amdgcn_mfma_f32_32x32x16_bf16(PAF(3),VFR(3),o[0],0,0,0), C1,8); \
    GAPB(o[1]=__builtin_amdgcn_mfma_f32_32x32x16_bf16(PAF(3),VFR(7),o[1],0,0,0), C1,12); \
    }while(0)
  int t=1;
  #undef CMASK
  #define CMASK(P0,P1,t) do{}while(0)
  for(;t+5<NT;t+=2){
    STEP(pB0,pB1,pA0,pA1,t,true,true,true);     WAIT_BAR(2); RESC(); ROT();
    STEP(pA0,pA1,pB0,pB1,t+1,true,true,true);   WAIT_BAR(2); RESC(); ROT();
  }
  #undef CMASK
  #define CMASK(P0,P1,t) do{int jb_=(t)-(NT-4); if(jb_>=0)cmask(P0,P1,jb_,qrel,hi);}while(0)
  #define ENDW(tt) do{ if((tt)+3<NT){WAIT_BAR(2);} else if((tt)+2<NT){WAIT_BAR(1);} else {WAIT_BAR(0);} }while(0)
  for(;t+1<NT;t+=2){
    STEP(pB0,pB1,pA0,pA1,t,(t+3<NT),(t+1<NT),(t+1<NT));       ENDW(t);   RESC(); ROT();
    STEP(pA0,pA1,pB0,pB1,t+1,(t+4<NT),(t+2<NT),(t+2<NT));     ENDW(t+1); RESC(); ROT();
  }
  STEP(pB0,pB1,pA0,pA1,NT-1,false,false,false); RESC();
  { float sacc=pB0[0]+pB0[1]; _Pragma("unroll") for(int r=2;r<16;++r)sacc+=pB0[r]; _Pragma("unroll") for(int r=0;r<16;++r)sacc+=pB1[r]; l_reg+=sacc;
    pw0=(u32x4){PKW(pB0,0),PKW(pB0,2),PKW(pB0,4),PKW(pB0,6)};pw1=(u32x4){PKW(pB0,8),PKW(pB0,10),PKW(pB0,12),PKW(pB0,14)};pw2=(u32x4){PKW(pB1,0),PKW(pB1,2),PKW(pB1,4),PKW(pB1,6)};pw3=(u32x4){PKW(pB1,8),PKW(pB1,10),PKW(pB1,12),PKW(pB1,14)};
    SBAR(); pv(o,vb0+sl_cur,PAF(0),PAF(1),PAF(2),PAF(3)); }
  #undef PKW
  #undef PAF
  #undef VFR
  #undef PIN
  #undef MX3
  #undef GAPA
  #undef GAPB
  #undef EX
  #undef VRD
  #undef KRD
  #undef STEP
  #undef ENDW
  {auto rr=__builtin_amdgcn_permlane32_swap(__float_as_uint(l_reg),__float_as_uint(l_reg),false,false);l_reg=__uint_as_float(rr[0])+__uint_as_float(rr[1]);}
  if(hi==0)wsf[32+r32]=l_reg;asm volatile("s_waitcnt lgkmcnt(0)":::"memory");
  float rli[16];
  #pragma unroll
  for(int r=0;r<16;++r)rli[r]=__builtin_amdgcn_rcpf(wsf[32+crow(r,hi)]);
  bf16*Ow=O+(rowbase+q0+wid*QBLK)*PO+ocol;
  { bf16*stg=(bf16*)(shm+LDS_OST)+wid*2048;
    #pragma unroll
    for(int r=0;r<16;++r){const int orow=crow(r,hi);
      #pragma unroll
      for(int d0=0;d0<2;++d0)stg[orow*64+d0*32+r32]=__float2bfloat16(o[d0][r]*rli[r]);}
    asm volatile("s_waitcnt lgkmcnt(0)":::"memory");
    #pragma unroll
    for(int i=0;i<4;++i){const int row=i*8+(lane>>3),ch=lane&7; const u32x4 v=*(const u32x4*)(stg+row*64+ch*8); ATTN_STORE16(Ow+(long)row*PO+ch*8,v);} }
  asm volatile("s_waitcnt lgkmcnt(0)\n\ts_barrier":::"memory");
  #undef DMA_K
  #undef DMA_V
  #undef CMASK
  #undef START
  #undef RESC
  #undef ROT
}
constexpr int ATTN_LDS_BYTES=LDS_BYTES;
struct AttnTensors { const bf16* Q; const bf16* K; const bf16* V; bf16* O; };
struct AttnUnit { int bh; int qb; };
struct StaticOrder {
  int vcu;
  __device__ __forceinline__ explicit StaticOrder(int grid,int block):vcu((block%8)*(grid/8)+block/8){}
  __device__ __forceinline__ bool next(int i,AttnUnit&u)const{ if(i>=4)return false; const int s=vcu&7; u.bh=vcu>>3; u.qb=(i==0)?s:(i==1)?15-s:(i==2)?16+s:31-s; return true; }
  __device__ __forceinline__ void a_ready(const AttnUnit&)const{}
  __device__ __forceinline__ void done(const AttnUnit&)const{}
};
template<class Sched,int THRL=8> __device__ __forceinline__ void attn_phase(char*lds,const AttnTensors&T,const Sched&S){
  AttnUnit u;
  for(int i=0;S.next(i,u);++i){ S.a_ready(u); const int ph=u.bh%NHEAD,hh=ph>>2,cc=(ph>>1)&1,vh=ph&1;
    attn_unit<THRL>(u.bh/NHEAD,hh*128+cc*64,hh*128+cc*64,hh*128+vh*64,ph*64,u.qb,T.Q,T.K,T.V,T.O,lds); S.done(u); }
}
#undef SBAR
#undef WAIT_BAR
}
constexpr int NWAVES = 8;
#ifndef MK_ONE_LAUNCH
#define MK_ONE_LAUNCH 0
#endif
constexpr int N_PHASES = 10;
#ifndef MK_DEC_STRIDE
#define MK_DEC_STRIDE 2
#endif
#ifndef MK_DPG
#define MK_DPG 2
#endif
constexpr int DPG = MK_DPG;
constexpr int DEC_STRIDE = MK_DEC_STRIDE;
#ifndef MK_REPEAT_MASK
#define MK_REPEAT_MASK 0
#endif
#ifndef MK_P3_LIST
#define MK_P3_LIST 112
#endif
constexpr size_t MiB = 1u << 20;
constexpr size_t WS_CTL = 0, CTL_ZERO_BYTES = 64 * 1024;
constexpr size_t WS_MODS = 1 * MiB;
constexpr size_t WS_ROPE = 5 * MiB;
constexpr size_t WS_QS = 6 * MiB;
constexpr size_t WS_MISC = 7 * MiB;
constexpr size_t WS_WIN = 8 * MiB, WS_WOUT = 13 * MiB, WS_WFI = 15 * MiB, WS_WFO = 26 * MiB;
constexpr size_t WS_XN = 32 * MiB;
constexpr size_t WS_U = 66 * MiB, WS_Q = 84 * MiB, WS_K = 102 * MiB, WS_V = 120 * MiB;
constexpr size_t WS_OP = 138 * MiB;
constexpr size_t WS_A2 = 172 * MiB;
constexpr size_t WS_X1 = 206 * MiB;
constexpr size_t WS_ACT = 272 * MiB;
constexpr size_t WS_END = 364 * MiB;
static_assert(WS_MODS + (size_t)130 * NMOD * 4 <= WS_ROPE && WS_ROPE + (size_t)8193 * 64 <= WS_QS && WS_WIN + (size_t)IN_W * DM * 2 <= WS_WOUT && WS_WOUT + (size_t)DM * DM * 2 <= WS_WFI &&
              WS_WFI + (size_t)2 * DFF * DM * 2 <= WS_WFO && WS_WFO + (size_t)DM * DFF * 2 <= WS_XN && WS_XN + (size_t)MPAD * DM * 2 <= WS_U && WS_U + (size_t)MPAD * CCH * 2 <= WS_Q &&
              WS_OP + (size_t)MP * DM * 2 <= WS_A2 && WS_A2 + (size_t)MPAD * DM * 2 <= WS_X1 && WS_X1 + (size_t)MPAD * DM * 4 <= WS_ACT && WS_ACT + (size_t)MPAD * DFF * 2 <= WS_END, "d_ws map");
constexpr int CW_TMO = 0, CW_BAR = 4096;
constexpr int CW_QA = 8192, CW_QD = 8256, CW_ST = 8320;
static_assert((CW_ST + 64 * 8 + 3 * 1024) * 4 <= (int)CTL_ZERO_BYTES, "CTL words inside the memset region");
constexpr int RING_OFF = 0, RING_BYTES = 131072;
constexpr int LDSCTL_OFF = RING_BYTES, MISC_OFF = LDSCTL_OFF + 320;
constexpr int LDS_BYTES = 147456;
#define GAS __attribute__((address_space(1)))
#define LAS __attribute__((address_space(3)))
typedef unsigned short bf16;
typedef unsigned v4u __attribute__((ext_vector_type(4)));
typedef float f32x4 __attribute__((ext_vector_type(4)));
typedef short bf16x8 __attribute__((ext_vector_type(8)));
typedef GAS unsigned gu32;
typedef GAS unsigned long long gu64;
#define RLX_AGENT __ATOMIC_RELAXED, __HIP_MEMORY_SCOPE_AGENT
#define LDS_WAIT() asm volatile("s_waitcnt lgkmcnt(0)" ::: "memory")
#define VM_WAIT() asm volatile("s_waitcnt vmcnt(0)" ::: "memory")
__device__ __forceinline__ unsigned long long rt() { return __builtin_amdgcn_s_memrealtime(); }
__device__ __forceinline__ unsigned f2bf(float f) { unsigned u = __builtin_bit_cast(unsigned, f); return (u + 0x7fffu + ((u >> 16) & 1u)) >> 16; }
__device__ __forceinline__ unsigned pk2(float lo, float hi) { return f2bf(lo) | (f2bf(hi) << 16); }

#define XB_TMO      128
#define XB_XCNT(j)  (256  + 64 * (j))
#define XB_XSUB(j)  (1280 + 64 * (j))
#define XB_XGEN(j)  (2304 + 64 * (j))
#define XB_TOP      3328
#define XB_TOPGEN   3392
#define XCD_BAR_WORDS 3456
#define XB_SPIN_CAP (1u << 18)

__device__ __forceinline__ unsigned xb_ld(unsigned* p)              { return __hip_atomic_load(p, __ATOMIC_RELAXED, __HIP_MEMORY_SCOPE_AGENT); }
__device__ __forceinline__ unsigned xb_add(unsigned* p, unsigned v) { return __hip_atomic_fetch_add(p, v, __ATOMIC_RELAXED, __HIP_MEMORY_SCOPE_AGENT); }
__device__ __forceinline__ unsigned xb_xcc_id() { return (unsigned)__builtin_amdgcn_s_getreg((3 << 11) | 20) & 0xFu; }
#define XB_SPIN(cond, bar) do { unsigned _sp = 0; while (cond) { __builtin_amdgcn_s_sleep(1); \
    if ((++_sp & 255u) == 0u) { if (xb_ld(&(bar)[XB_TMO])) break; if (_sp > XB_SPIN_CAP) { atomicAdd(&(bar)[XB_TMO], 1u); break; } } } } while (0)

struct XcdBarrier {
    unsigned* bar; unsigned x;
    volatile LAS unsigned* st;
};

__device__ __forceinline__ XcdBarrier xcd_barrier_post(unsigned* bar, volatile LAS unsigned* st) {
    XcdBarrier b; b.bar = bar; b.x = xb_xcc_id(); b.st = st;
    if (threadIdx.x == 0) (void)xb_add(&bar[XB_XCNT(b.x)], 1u);
    return b;
}
__device__ __forceinline__ void xcd_barrier_complete(unsigned* bar, unsigned x, unsigned& nloc, unsigned& nx) {
    const unsigned G = gridDim.x * gridDim.y * gridDim.z;
    unsigned sum, cnt, mine, sp = 0u;
    for (;;) {
        sum = 0u; cnt = 0u; mine = 0u;
#pragma unroll
        for (unsigned j = 0; j < 16; ++j) { const unsigned c = xb_ld(&bar[XB_XCNT(j)]); sum += c; cnt += (c > 0u) ? 1u : 0u; mine = (j == x) ? c : mine; }
        if (sum == G) break;
        __builtin_amdgcn_s_sleep(1);
        if ((++sp & 255u) == 0u) { if (xb_ld(&bar[XB_TMO])) break; if (sp > XB_SPIN_CAP) { atomicAdd(&bar[XB_TMO], 1u); break; } }
    }
    nloc = mine > 0u ? mine : 1u; nx = cnt > 0u ? cnt : 1u;
}

__device__ __forceinline__ void xcd_barrier(const XcdBarrier& b) {
    asm volatile("s_waitcnt vmcnt(0)" ::: "memory");
    __syncthreads();
    if (threadIdx.x == 0) {
        unsigned* bar = b.bar;
        __builtin_amdgcn_s_waitcnt(0);
        unsigned nloc = b.st[0], nx = b.st[1];
        if (nloc == 0u) { xcd_barrier_complete(bar, b.x, nloc, nx); b.st[0] = nloc; b.st[1] = nx; }
        const unsigned old = xb_add(&bar[XB_XSUB(b.x)], 1u);
        const unsigned gen = old / nloc;
        if (old + 1u == (gen + 1u) * nloc) {
            __builtin_amdgcn_fence(__ATOMIC_RELEASE, "agent");
            asm volatile("s_waitcnt vmcnt(0)" ::: "memory");
            const unsigned og = xb_add(&bar[XB_TOP], 1u);
            const unsigned tg = og / nx;
            if (og + 1u == (tg + 1u) * nx) xb_add(&bar[XB_TOPGEN], 1u);
            else XB_SPIN(xb_ld(&bar[XB_TOPGEN]) == tg, bar);
            __builtin_amdgcn_fence(__ATOMIC_ACQUIRE, "agent");
            xb_add(&bar[XB_XGEN(b.x)], 1u);
            asm volatile("s_waitcnt vmcnt(0)" ::: "memory");
        } else {
            XB_SPIN(xb_ld(&bar[XB_XGEN(b.x)]) == gen, bar);
            __builtin_amdgcn_fence(__ATOMIC_ACQUIRE, "agent");
            asm volatile("s_waitcnt vmcnt(0)" ::: "memory");
        }
    }
    __syncthreads();
}

struct Frame { LAS unsigned char* lds; int tid, lane, wave, vcu, G; };
struct Args { const void* in[26]; float* out; unsigned char* ws; int ph_lo, ph_hi, one, p3mode, p3set, pad; };
enum In { I_XP = 0, I_XS, I_CK, I_CV, I_SC, I_PT, I_CP, I_CS, I_GMIX, I_GFFN, I_GFIN, I_WADA, I_BADA, I_WIN, I_DWW, I_DWB, I_LNG, I_LNB, I_LQ1, I_LK1, I_LQ2, I_LK2, I_SUBG, I_WOUT, I_WFI, I_WFO };

__device__ __forceinline__ const void* ldptr(LAS unsigned long long* tab, int i) {
    const unsigned long long v = tab[i]; const unsigned lo = __builtin_amdgcn_readfirstlane((unsigned)v), hi = __builtin_amdgcn_readfirstlane((unsigned)(v >> 32));
    return (const void*)(const GAS void*)(((unsigned long long)hi << 32) | lo);
}
__device__ __forceinline__ float wave_sum(float v) {
#pragma unroll
    for (int o = 1; o < 64; o <<= 1) v += __shfl_xor(v, o);
    return v;
}
__device__ __forceinline__ float wave_max(float v) {
#pragma unroll
    for (int o = 1; o < 64; o <<= 1) v = fmaxf(v, __shfl_xor(v, o));
    return v;
}
template <int CTRL> __device__ __forceinline__ float dppf(float x) { return __int_as_float(__builtin_amdgcn_update_dpp(0, __float_as_int(x), CTRL, 0xf, 0xf, true)); }
__device__ __forceinline__ float row16_sum(float x) {
    x += dppf<0xB1>(x); x += dppf<0x4E>(x); x += dppf<0x141>(x); x += dppf<0x140>(x); return x;
}
__device__ __forceinline__ float bf2f(unsigned short b) { return __uint_as_float((unsigned)b << 16); }
__device__ __forceinline__ void st_wt(float* p, float v) { __hip_atomic_store((GAS unsigned*)p, __float_as_uint(v), RLX_AGENT); }
__device__ __forceinline__ void st_wt(bf16* p, unsigned v) { __hip_atomic_store((GAS unsigned short*)p, (unsigned short)v, RLX_AGENT); }
__device__ __forceinline__ void st_wt64(void* p, unsigned long long v) { __hip_atomic_store((GAS unsigned long long*)p, v, RLX_AGENT); }
__device__ __forceinline__ float block_sum(const Frame& F, LAS float* red, float v) {
    v = wave_sum(v); if (F.lane == 0) red[F.wave] = v; __syncthreads();
    float r = 0.f;
#pragma unroll
    for (int i = 0; i < NWAVES; ++i) r += red[i];
    __syncthreads(); return r;
}
__device__ __forceinline__ float block_max(const Frame& F, LAS float* red, float v) {
    v = wave_max(v); if (F.lane == 0) red[F.wave] = v; __syncthreads();
    float r = red[0];
#pragma unroll
    for (int i = 1; i < NWAVES; ++i) r = fmaxf(r, red[i]);
    __syncthreads(); return r;
}

__device__ __forceinline__ void ada_unit(const Frame& F, int unit, const float* w_ada, const float* b_ada, const float* c_p, const float* c_s, float* mods) {
    constexpr int WST = 1032;
    const int n0 = unit * 32, c4 = F.tid & 7, kp = F.tid >> 3;
    LAS unsigned* Wl32 = (LAS unsigned*)F.lds;
#pragma unroll
    for (int p = 0; p < 8; p += 4) {
        f32x4 a[4], b[4];
#pragma unroll
        for (int q = 0; q < 4; ++q) { const int k = 2 * kp + 128 * (p + q); a[q] = *(const GAS f32x4*)(w_ada + (size_t)k * NMOD + n0 + 4 * c4); b[q] = *(const GAS f32x4*)(w_ada + (size_t)(k + 1) * NMOD + n0 + 4 * c4); }
#pragma unroll
        for (int q = 0; q < 4; ++q) { const int k = 2 * kp + 128 * (p + q);
#pragma unroll
            for (int i = 0; i < 4; ++i) Wl32[((4 * c4 + i) * WST + k) >> 1] = pk2(a[q][i], b[q][i]); }
    }
    __syncthreads();
    const int fr = F.lane & 15, fq = F.lane >> 4;
    for (int mt = F.wave; mt < 9; mt += NWAVES) {
        f32x4 acc0 = {0.f, 0.f, 0.f, 0.f}, acc1 = acc0;
        const int r = mt * 16 + fr;
        const float* crow = r < 2 ? c_p + (size_t)r * DM : c_s + (size_t)(r < 130 ? r - 2 : 0) * DM;
        const bool live = r < 130;
#pragma unroll 4
        for (int s = 0; s < 32; ++s) { const int k = 32 * s + 8 * fq;
            f32x4 x0 = *(const GAS f32x4*)(crow + k), x1 = *(const GAS f32x4*)(crow + k + 4);
#pragma unroll
            for (int i = 0; i < 4; ++i) { x0[i] = live ? x0[i] * __builtin_amdgcn_rcpf(1.0f + __expf(-x0[i])) : 0.f; x1[i] = live ? x1[i] * __builtin_amdgcn_rcpf(1.0f + __expf(-x1[i])) : 0.f; }
            v4u aw; aw.x = pk2(x0[0], x0[1]); aw.y = pk2(x0[2], x0[3]); aw.z = pk2(x1[0], x1[1]); aw.w = pk2(x1[2], x1[3]);
            const bf16x8 A = __builtin_bit_cast(bf16x8, aw);
            const bf16x8 B0 = *(const LAS bf16x8*)(F.lds + ((size_t)fr * WST + k) * 2), B1 = *(const LAS bf16x8*)(F.lds + ((size_t)(16 + fr) * WST + k) * 2);
            acc0 = __builtin_amdgcn_mfma_f32_16x16x32_bf16(A, B0, acc0, 0, 0, 0); acc1 = __builtin_amdgcn_mfma_f32_16x16x32_bf16(A, B1, acc1, 0, 0, 0); }
        const float bb0 = b_ada[n0 + fr], bb1 = b_ada[n0 + 16 + fr];
#pragma unroll
        for (int g = 0; g < 4; ++g) { const int rr = mt * 16 + 4 * fq + g; if (rr < 130) { mods[(size_t)rr * NMOD + n0 + fr] = acc0[g] + bb0; mods[(size_t)rr * NMOD + n0 + 16 + fr] = acc1[g] + bb1; } }
    }
    __syncthreads();
}
__device__ __forceinline__ void p0_transpose_item(const float* W, int K, int N, bf16* WT, int drow0, LAS float* scr, int kb, int nb, int lane) {
    const int k0 = 64 * kb, n0 = 32 * nb;
#pragma unroll 8
    for (int i = 0; i < 32; ++i) { const int kk = 2 * i + (lane >> 5); scr[kk * 33 + (lane & 31)] = W[(size_t)(k0 + kk) * N + n0 + (lane & 31)]; }
    LDS_WAIT(); asm volatile("" ::: "memory");
    const int c = lane & 7;
#pragma unroll
    for (int j = 0; j < 4; ++j) { const int n = (lane >> 3) + 8 * j; const LAS float* s = scr + (8 * c) * 33 + n;
        v4u o; o.x = pk2(s[0 * 33], s[1 * 33]); o.y = pk2(s[2 * 33], s[3 * 33]); o.z = pk2(s[4 * 33], s[5 * 33]); o.w = pk2(s[6 * 33], s[7 * 33]);
        *(GAS v4u*)(WT + (size_t)(drow0 + n) * K + k0 + 8 * c) = o; }
    LDS_WAIT(); asm volatile("" ::: "memory");
}
__device__ __forceinline__ int glu_row(int n0, int half) { return n0 < half ? ((n0 >> 7) << 8) + (n0 & 127) : (((n0 - half) >> 7) << 8) + 128 + ((n0 - half) & 127); }
__device__ __forceinline__ void phase0(const Frame& F, LAS unsigned long long* PT, unsigned char* ws) {
    for (int unit = F.vcu; unit < NMOD / 32; unit += F.G) ada_unit(F, unit, (const float*)ldptr(PT, I_WADA), (const float*)ldptr(PT, I_BADA), (const float*)ldptr(PT, I_CP), (const float*)ldptr(PT, I_CS), (float*)(ws + WS_MODS));
    LAS float* scr = (LAS float*)(F.lds + RING_OFF + F.wave * 16384);
    const int gw = F.vcu * NWAVES + F.wave, NGW = F.G * NWAVES;
    constexpr int I_IN = 16 * (IN_W / 32), I_OUT = 16 * (DM / 32), I_FI = 16 * (2 * DFF / 32), I_FO = (DFF / 64) * (DM / 32), NITEMS = I_IN + I_OUT + I_FI + I_FO;
    for (int it = gw; it < NITEMS; it += NGW) {
        int r = it;
        if (r < I_IN) { const int kb = r / (IN_W / 32), nb = r % (IN_W / 32), n0 = nb * 32; p0_transpose_item((const float*)ldptr(PT, I_WIN), DM, IN_W, (bf16*)(ws + WS_WIN), n0 < 2 * CCH ? glu_row(n0, CCH) : n0, scr, kb, nb, F.lane); continue; } r -= I_IN;
        if (r < I_OUT) { const int kb = r / (DM / 32), nb = r % (DM / 32); p0_transpose_item((const float*)ldptr(PT, I_WOUT), DM, DM, (bf16*)(ws + WS_WOUT), nb * 32, scr, kb, nb, F.lane); continue; } r -= I_OUT;
        if (r < I_FI) { const int kb = r / (2 * DFF / 32), nb = r % (2 * DFF / 32); p0_transpose_item((const float*)ldptr(PT, I_WFI), DM, 2 * DFF, (bf16*)(ws + WS_WFI), glu_row(nb * 32, DFF), scr, kb, nb, F.lane); continue; } r -= I_FI;
        { const int kb = r / (DM / 32), nb = r % (DM / 32); p0_transpose_item((const float*)ldptr(PT, I_WFO), DFF, DM, (bf16*)(ws + WS_WFO), nb * 32, scr, kb, nb, F.lane); }
    }
    float* rope = (float*)(ws + WS_ROPE);
    for (int idx = F.vcu * (NWAVES * 64) + F.tid; idx < 8193 * 8; idx += F.G * NWAVES * 64) {
        const int pos = idx >> 3, i = idx & 7;
        const float inv = i == 0 ? 1.0f : i == 1 ? 0.1939227432012558f : i == 2 ? 0.03760603070259094f : i == 3 ? 0.007292664609849453f : i == 4 ? 0.0014142135623842478f : i == 5 ? 0.00027424818836152554f : i == 6 ? 5.3182957344688475e-05f : 1.0313385246263351e-05f;
        const float angf = __fmul_rn((float)pos, inv);
        const double x = (double)angf, n = rint(x * 0.15915494309189535);
        double rr = fma(-n, 6.283185307179586, x); rr = fma(-n, 2.4492935982947064e-16, rr);
        const double r2 = rr * rr;
        double sn = 1.0 / 25852016738884976640000.0, cs = 1.0 / 620448401733239439360000.0;
        const double fs[11] = {1.0 / 51090942171709440000.0, 1.0 / 121645100408832000.0, 1.0 / 355687428096000.0, 1.0 / 1307674368000.0, 1.0 / 6227020800.0, 1.0 / 39916800.0, 1.0 / 362880.0, 1.0 / 5040.0, 1.0 / 120.0, 1.0 / 6.0, 1.0};
        const double fc[12] = {1.0 / 1124000727777607680000.0, 1.0 / 2432902008176640000.0, 1.0 / 6402373705728000.0, 1.0 / 20922789888000.0, 1.0 / 87178291200.0, 1.0 / 479001600.0, 1.0 / 3628800.0, 1.0 / 40320.0, 1.0 / 720.0, 1.0 / 24.0, 1.0 / 2.0, 1.0};
#pragma unroll
        for (int t = 0; t < 11; ++t) sn = fs[t] - sn * r2;
#pragma unroll
        for (int t = 0; t < 12; ++t) cs = fc[t] - cs * r2;
        sn *= rr;
        rope[pos * 16 + i] = (float)cs; rope[pos * 16 + 8 + i] = (float)sn;
    }
    if (F.vcu == 0 && F.wave == 0) {
        const float s1 = wave_sum(((const float*)ldptr(PT, I_LQ1))[F.lane] * ((const float*)ldptr(PT, I_LK1))[F.lane]), s2 = wave_sum(((const float*)ldptr(PT, I_LQ2))[F.lane] * ((const float*)ldptr(PT, I_LK2))[F.lane]);
        if (F.lane == 0) ((float*)(ws + WS_MISC))[0] = expf(s1) - expf(s2) + LAM_INIT;
    }
}
__device__ __forceinline__ void modnorm_phase(const Frame& F, const float* srcp, const float* srcs, const float* gain, const float* mods, int sh_off, int sc_off, bf16* dst, int nrows) {
    const int gw = F.vcu * NWAVES + F.wave, NGW = F.G * NWAVES;
    for (int m = gw; m < nrows; m += NGW) {
        GAS unsigned long long* o8 = (GAS unsigned long long*)(dst + (size_t)m * DM) + F.lane;
        const float* xrow = m < MP ? srcp + (size_t)m * DM : srcs + (size_t)(m - MP) * DM;
        const float* mrow = mods + (size_t)(m < MP ? (m >> 13) : 2 + m - MP) * NMOD;
        const GAS f32x4* xr = (const GAS f32x4*)xrow + F.lane;
        f32x4 v[4]; float s = 0.f;
#pragma unroll
        for (int j = 0; j < 4; ++j) { v[j] = xr[64 * j]; s += (v[j].x * v[j].x + v[j].y * v[j].y) + (v[j].z * v[j].z + v[j].w * v[j].w); }
        const float rstd = 1.0f / sqrtf(wave_sum(s) * (1.f / DM) + NORM_EPS);
#pragma unroll
        for (int j = 0; j < 4; ++j) { const int col = 4 * (F.lane + 64 * j);
            const f32x4 g = *(const GAS f32x4*)(gain + col), sc = *(const GAS f32x4*)(mrow + sc_off + col), sh = *(const GAS f32x4*)(mrow + sh_off + col);
            const f32x4 o = v[j] * rstd * g * (sc + 1.0f) + sh;
            o8[64 * j] = (unsigned long long)pk2(o.x, o.y) | ((unsigned long long)pk2(o.z, o.w) << 32); }
    }
}
__device__ __forceinline__ void finalnorm_phase(const Frame& F, float* y, const float* gain) {
    const int gw = F.vcu * NWAVES + F.wave, NGW = F.G * NWAVES;
    for (int m = gw; m < MP; m += NGW) {
        GAS f32x4* xr = (GAS f32x4*)(y + (size_t)m * DM) + F.lane;
        f32x4 v[4]; float s = 0.f;
#pragma unroll
        for (int j = 0; j < 4; ++j) { v[j] = xr[64 * j]; s += (v[j].x * v[j].x + v[j].y * v[j].y) + (v[j].z * v[j].z + v[j].w * v[j].w); }
        const float rstd = 1.0f / sqrtf(wave_sum(s) * (1.f / DM) + NORM_EPS);
#pragma unroll
        for (int j = 0; j < 4; ++j) xr[64 * j] = v[j] * rstd * *(const GAS f32x4*)(gain + 4 * (F.lane + 64 * j));
    }
}
__device__ __forceinline__ void conv_unit(const Frame& F, int b, int tile, const bf16* U, const float* dww, const float* dwb, const float* lng, const float* lnb, bf16* A2, float* out) {
    LAS float* YL = (LAS float*)F.lds;
    const int c = F.tid, t0 = tile * 32; const size_t base = (size_t)b * SEQ;
    float w[CWID];
#pragma unroll
    for (int j = 0; j < CWID; ++j) w[j] = dww[j * CCH + c];
    const float bias = dwb[c];
    float h[CWID];
    h[0] = 0.f;
#pragma unroll
    for (int j = 0; j < CWID - 1; ++j) { const int r = t0 - (CWID - 1) + j; h[j + 1] = r >= 0 ? bf2f(U[(base + r) * CCH + c]) : 0.f; }
    float cur[32];
#pragma unroll
    for (int tt = 0; tt < 32; ++tt) cur[tt] = bf2f(U[(base + t0 + tt) * CCH + c]);
#pragma unroll
    for (int tt = 0; tt < 32; ++tt) {
#pragma unroll
        for (int j = 0; j < CWID - 1; ++j) h[j] = h[j + 1];
        h[CWID - 1] = cur[tt];
        float y = bias;
#pragma unroll
        for (int j = 0; j < CWID; ++j) y = fmaf(w[j], h[j], y);
        YL[tt * CCH + c] = y;
        if (t0 + tt >= SEQ - (CWID - 1)) out[OFF_CP + (size_t)b * (CWID - 1) * CCH + (size_t)(t0 + tt - (SEQ - (CWID - 1))) * CCH + c] = cur[tt];
    }
    __syncthreads();
    const int c0 = 8 * F.lane;
    const f32x4 g0 = *(const GAS f32x4*)(lng + c0), g1 = *(const GAS f32x4*)(lng + c0 + 4), b0 = *(const GAS f32x4*)(lnb + c0), b1 = *(const GAS f32x4*)(lnb + c0 + 4);
#pragma unroll
    for (int q = 0; q < 4; ++q) { const int tt = 4 * F.wave + q;
        f32x4 v0 = *(const LAS f32x4*)(YL + tt * CCH + c0), v1 = *(const LAS f32x4*)(YL + tt * CCH + c0 + 4);
        const float mean = wave_sum((v0.x + v0.y) + (v0.z + v0.w) + (v1.x + v1.y) + (v1.z + v1.w)) * (1.f / CCH);
        v0 = v0 - mean; v1 = v1 - mean;
        const float var = wave_sum((v0.x * v0.x + v0.y * v0.y) + (v0.z * v0.z + v0.w * v0.w) + (v1.x * v1.x + v1.y * v1.y) + (v1.z * v1.z + v1.w * v1.w)) * (1.f / CCH);
        const float rstd = 1.0f / sqrtf(var + NORM_EPS);
        v0 = v0 * rstd * g0 + b0; v1 = v1 * rstd * g1 + b1;
#pragma unroll
        for (int i = 0; i < 4; ++i) { v0[i] *= __builtin_amdgcn_rcpf(1.0f + __expf(-v0[i])); v1[i] *= __builtin_amdgcn_rcpf(1.0f + __expf(-v1[i])); }
        v4u o; o.x = pk2(v0.x, v0.y); o.y = pk2(v0.z, v0.w); o.z = pk2(v1.x, v1.y); o.w = pk2(v1.z, v1.w);
        *(GAS v4u*)(A2 + (base + t0 + tt) * DM + c0) = o; }
    __syncthreads();
}
__device__ __forceinline__ void dec_conv_unit(const Frame& F, int b, const float* state, const float* dww, const float* dwb, const float* lng, const float* lnb, bf16* A2, float* out) {
    LAS float* red = (LAS float*)F.lds;
    const int c = F.tid; const float* st = state + (size_t)b * (CWID - 1) * CCH; float* cs = out + OFF_CS + (size_t)b * (CWID - 1) * CCH;
    float y = dwb[c];
#pragma unroll
    for (int j = 0; j < CWID - 1; ++j) { const float s = st[j * CCH + c]; y = fmaf(dww[j * CCH + c], s, y); if (j >= 1) cs[(j - 1) * CCH + c] = s; }
    y = fmaf(dww[(CWID - 1) * CCH + c], cs[(CWID - 2) * CCH + c], y);
    const float mean = block_sum(F, red, y) * (1.f / CCH), d = y - mean, var = block_sum(F, red, d * d) * (1.f / CCH);
    float v = d * (1.0f / sqrtf(var + NORM_EPS)) * lng[c] + lnb[c]; v *= __builtin_amdgcn_rcpf(1.0f + __expf(-v));
    st_wt(A2 + (size_t)(MP + b) * DM + c, f2bf(v));
}
__device__ __forceinline__ void dec_attn_unit(const Frame& F, int b, int h, const float* ck, const float* cv, const int* ptab, const float* QS, const float* out, const float* subg, float lam, bf16* A2) {
    LAS float* ML = (LAS float*)F.lds;
    LAS float* O1 = ML + 80; LAS float* O2 = O1 + 17 * 128; LAS float* red = O2 + 17 * 128;
    const int lane = F.lane, wave = F.wave, ts = lane >> 5, part = (lane >> 4) & 1, d4 = lane & 15, d4v = lane & 31;
    const int pv = ptab[b * NPAGE + (lane & 15)];
    const f32x4 qv = *(const GAS f32x4*)(QS + (size_t)b * CCH + h * 128 + part * 64 + 4 * d4);
    const size_t koff = (size_t)h * 128 + part * 64 + 4 * d4 + (size_t)(wave * 2 + ts) * 512, voff = (size_t)h * 128 + 4 * d4v + (size_t)(wave * 2 + ts) * 512;
    float m1 = -1e30f, m2 = -1e30f, l1 = 0.f, l2 = 0.f; f32x4 o1 = {0.f, 0.f, 0.f, 0.f}, o2 = o1;
    f32x4 kA[8], vA[8], kB[8], vB[8];
#define DA_LOAD(KB_, VB_, g) do { const int page_ = __builtin_amdgcn_readlane(pv, (g)); const float* kp_ = ck + (size_t)page_ * (PAGE * 512) + koff; const float* vp_ = cv + (size_t)page_ * (PAGE * 512) + voff; \
        _Pragma("unroll") for (int i = 0; i < 8; ++i) { KB_[i] = __builtin_nontemporal_load((const GAS f32x4*)(kp_ + (size_t)i * (16 * 512))); VB_[i] = __builtin_nontemporal_load((const GAS f32x4*)(vp_ + (size_t)i * (16 * 512))); } } while (0)
#define DA_COMP(KB_, VB_) do { float s1_[8], s2_[8]; float bm1 = m1, bm2 = m2; \
        _Pragma("unroll") for (int i = 0; i < 8; ++i) { float p = (qv.x * KB_[i].x + qv.y * KB_[i].y) + (qv.z * KB_[i].z + qv.w * KB_[i].w); p = row16_sum(p); \
            const float q_ = __int_as_float(__builtin_amdgcn_ds_swizzle(__float_as_int(p), 0x401F)); s1_[i] = part ? q_ : p; s2_[i] = part ? p : q_; bm1 = fmaxf(bm1, s1_[i]); bm2 = fmaxf(bm2, s2_[i]); } \
        const float c1 = __builtin_amdgcn_exp2f(m1 - bm1), c2 = __builtin_amdgcn_exp2f(m2 - bm2); m1 = bm1; m2 = bm2; l1 *= c1; l2 *= c2; o1 = o1 * c1; o2 = o2 * c2; \
        _Pragma("unroll") for (int i = 0; i < 8; ++i) { const float e1 = __builtin_amdgcn_exp2f(s1_[i] - m1), e2 = __builtin_amdgcn_exp2f(s2_[i] - m2); l1 += e1; l2 += e2; o1 += VB_[i] * e1; o2 += VB_[i] * e2; } } while (0)
    DA_LOAD(kA, vA, 0);
#pragma unroll 1
    for (int g = 0; g < NPAGE; g += 2) {
        DA_LOAD(kB, vB, g + 1);
        DA_COMP(kA, vA);
        if (g + 2 < NPAGE) DA_LOAD(kA, vA, g + 2);
        DA_COMP(kB, vB);
    }
#undef DA_LOAD
#undef DA_COMP
    { const int p = wave * 2 + ts; if (d4v == 0) { ML[p * 4 + 0] = m1; ML[p * 4 + 1] = l1; ML[p * 4 + 2] = m2; ML[p * 4 + 3] = l2; }
      *(LAS f32x4*)(O1 + p * 128 + 4 * d4v) = o1; *(LAS f32x4*)(O2 + p * 128 + 4 * d4v) = o2; }
    if (wave == 0) {
        const f32x4 kn = *(const GAS f32x4*)(out + OFF_KS + (size_t)b * CCH + h * 128 + part * 64 + 4 * d4);
        float p = (qv.x * kn.x + qv.y * kn.y) + (qv.z * kn.z + qv.w * kn.w); p = row16_sum(p);
        const float q_ = __int_as_float(__builtin_amdgcn_ds_swizzle(__float_as_int(p), 0x401F));
        if (lane == 0) { ML[16 * 4 + 0] = part ? q_ : p; ML[16 * 4 + 1] = 1.f; ML[16 * 4 + 2] = part ? p : q_; ML[16 * 4 + 3] = 1.f; }
        if (lane < 32) { const f32x4 vn = *(const GAS f32x4*)(out + OFF_VS + (size_t)b * CCH + h * 128 + 4 * d4v); *(LAS f32x4*)(O1 + 16 * 128 + 4 * d4v) = vn; *(LAS f32x4*)(O2 + 16 * 128 + 4 * d4v) = vn; }
    }
    __syncthreads();
    float o = 0.f;
    if (F.tid < 128) {
        float M1 = ML[0], M2 = ML[2];
#pragma unroll
        for (int p = 1; p < 17; ++p) { M1 = fmaxf(M1, ML[p * 4]); M2 = fmaxf(M2, ML[p * 4 + 2]); }
        float L1 = 0.f, L2 = 0.f, a1 = 0.f, a2 = 0.f;
#pragma unroll
        for (int p = 0; p < 17; ++p) { const float w1 = __builtin_amdgcn_exp2f(ML[p * 4] - M1), w2 = __builtin_amdgcn_exp2f(ML[p * 4 + 2] - M2);
            L1 = fmaf(ML[p * 4 + 1], w1, L1); L2 = fmaf(ML[p * 4 + 3], w2, L2); a1 = fmaf(O1[p * 128 + F.tid], w1, a1); a2 = fmaf(O2[p * 128 + F.tid], w2, a2); }
        o = a1 / L1 - lam * (a2 / L2);
    }
    const float ss = block_sum(F, red, F.tid < 128 ? o * o : 0.f);
    if (F.tid < 128) st_wt(A2 + (size_t)(MP + b) * DM + CCH + h * 128 + F.tid, f2bf(o * (1.0f / sqrtf(ss * (1.f / 128.f) + NORM_EPS)) * subg[F.tid] * (1.0f - LAM_INIT)));
    __syncthreads();
}
__device__ __forceinline__ void combine_phase(const Frame& F, const bf16* OP, const float* subg, float lam, bf16* A2) {
    const int gw = F.vcu * NWAVES + F.wave, NGW = F.G * NWAVES, hh = F.lane >> 4, d0 = 8 * (F.lane & 15);
    const f32x4 g0 = *(const GAS f32x4*)(subg + d0), g1 = *(const GAS f32x4*)(subg + d0 + 4);
    for (int m = gw; m < MP; m += NGW) {
        const v4u a = *(const GAS v4u*)(OP + (size_t)m * DM + hh * 256 + d0), b = *(const GAS v4u*)(OP + (size_t)m * DM + hh * 256 + 128 + d0);
        float o[8];
#pragma unroll
        for (int i = 0; i < 4; ++i) { o[2 * i] = __uint_as_float(a[i] << 16) - lam * __uint_as_float(b[i] << 16); o[2 * i + 1] = __uint_as_float(a[i] & 0xffff0000u) - lam * __uint_as_float(b[i] & 0xffff0000u); }
        float ss = 0.f;
#pragma unroll
        for (int i = 0; i < 8; ++i) ss += o[i] * o[i];
        const float sc = (1.0f / sqrtf(row16_sum(ss) * (1.f / 128.f) + NORM_EPS)) * (1.0f - LAM_INIT);
        v4u w; w.x = pk2(o[0] * sc * g0.x, o[1] * sc * g0.y); w.y = pk2(o[2] * sc * g0.z, o[3] * sc * g0.w); w.z = pk2(o[4] * sc * g1.x, o[5] * sc * g1.y); w.w = pk2(o[6] * sc * g1.z, o[7] * sc * g1.w);
        *(GAS v4u*)(A2 + (size_t)m * DM + CCH + hh * 128 + d0) = w;
    }
}
constexpr int ND1 = 80, NDA = 640, ND2 = 32, NDN = 16, ND3 = 176, ND4 = 32, NDF = 16;
constexpr int TD1 = 0, TDA = TD1 + ND1, TD2 = TDA + NDA, TDN = TD2 + ND2, TD3 = TDN + NDN, TD4 = TD3 + ND3, TDF = TD4 + ND4, NQD = TDF + NDF;
constexpr int NQA_ATT = 1024, NQA = NQA_ATT + 2 * (SEQ / 32);
__device__ __forceinline__ void stage_wait(const Frame& F, gu32* cnt, unsigned want, gu32* tmo) {
    if (F.wave == 0) {
        unsigned sp = 0;
        while ((unsigned)__builtin_amdgcn_readfirstlane((int)__hip_atomic_load(cnt, RLX_AGENT)) < want) { __builtin_amdgcn_s_sleep(4); if (++sp > (1u << 20)) { if (F.lane == 0) __hip_atomic_store(tmo, 1u, RLX_AGENT); break; } }
        __builtin_amdgcn_fence(__ATOMIC_ACQUIRE, "agent");
    }
    asm volatile("s_waitcnt vmcnt(0)" ::: "memory");
    __syncthreads();
}
__device__ __forceinline__ void stage_signal(const Frame& F, gu32* cnt) {
    asm volatile("s_waitcnt vmcnt(0)" ::: "memory");
    __syncthreads();
    if (F.tid == 0) __hip_atomic_fetch_add(cnt, 1u, RLX_AGENT);
}
template <int K> __device__ __forceinline__ void dgemm_unit(const Frame& F, const bf16* A, const bf16* Bt, int nA, int nB, f32x4& cA, f32x4& cB) {
    constexpr int KW = K / NWAVES, NS = KW / 32;
    static_assert(K % (NWAVES * 32) == 0, "dgemm_unit: K must split into 32-deep steps over 8 waves");
    const int fr = F.lane & 15, fq = F.lane >> 4, kb = F.wave * KW + 8 * fq;
    const bf16* ap = A + (size_t)fr * K + kb; const bf16* bA = Bt + (size_t)(nA + fr) * K + kb; const bf16* bB = Bt + (size_t)(nB + fr) * K + kb;
    f32x4 acc[8][2];
#pragma unroll
    for (int mt = 0; mt < 8; ++mt) { acc[mt][0] = (f32x4){0.f, 0.f, 0.f, 0.f}; acc[mt][1] = (f32x4){0.f, 0.f, 0.f, 0.f}; }
#pragma unroll
    for (int s0 = 0; s0 < NS; s0 += 2) {
        bf16x8 a[2][8], b[2][2];
#pragma unroll
        for (int u = 0; u < 2; ++u) if (s0 + u < NS) {
#pragma unroll
            for (int mt = 0; mt < 8; ++mt) a[u][mt] = *(const GAS bf16x8*)(ap + (size_t)mt * 16 * K + (s0 + u) * 32);
            b[u][0] = *(const GAS bf16x8*)(bA + (s0 + u) * 32); b[u][1] = *(const GAS bf16x8*)(bB + (s0 + u) * 32); }
#pragma unroll
        for (int u = 0; u < 2; ++u) if (s0 + u < NS) {
#pragma unroll
            for (int mt = 0; mt < 8; ++mt) { acc[mt][0] = __builtin_amdgcn_mfma_f32_16x16x32_bf16(a[u][mt], b[u][0], acc[mt][0], 0, 0, 0); acc[mt][1] = __builtin_amdgcn_mfma_f32_16x16x32_bf16(a[u][mt], b[u][1], acc[mt][1], 0, 0, 0); } }
    }
    LAS f32x4* P = (LAS f32x4*)F.lds;
#pragma unroll
    for (int mt = 0; mt < 8; ++mt) { P[((F.wave * 8 + mt) * 2 + 0) * 64 + F.lane] = acc[mt][0]; P[((F.wave * 8 + mt) * 2 + 1) * 64 + F.lane] = acc[mt][1]; }
    __syncthreads();
    cA = P[((0 * 8 + F.wave) * 2 + 0) * 64 + F.lane]; cB = P[((0 * 8 + F.wave) * 2 + 1) * 64 + F.lane];
#pragma unroll
    for (int w = 1; w < NWAVES; ++w) { cA += P[((w * 8 + F.wave) * 2 + 0) * 64 + F.lane]; cB += P[((w * 8 + F.wave) * 2 + 1) * 64 + F.lane]; }
    __syncthreads();
}
__device__ __forceinline__ float silu_f(float x) { return x * __builtin_amdgcn_rcpf(1.0f + __expf(-x)); }
__device__ __forceinline__ void d1_unit(const Frame& F, int j, const bf16* XNd, const bf16* WinT, const float* rope, float* QS, float* out) {
    f32x4 cA, cB; const int c = F.lane & 15, r0 = 16 * F.wave + 4 * (F.lane >> 4);
    if (j < 32) {
        const int nA = ((j >> 3) << 8) + ((j & 7) << 4);
        dgemm_unit<DM>(F, XNd, WinT, nA, nA + 128, cA, cB);
#pragma unroll
        for (int g = 0; g < 4; ++g) st_wt(out + OFF_CS + (size_t)(r0 + g) * ((CWID - 1) * CCH) + (CWID - 2) * CCH + 16 * j + c, cA[g] * __builtin_amdgcn_rcpf(1.0f + __expf(-cB[g])));
    } else {
        const int n0 = 2 * CCH + 32 * (j - 32), col0 = n0 - 2 * CCH, reg = col0 >> 9, cc = col0 & (CCH - 1);
        dgemm_unit<DM>(F, XNd, WinT, n0, n0 + 16, cA, cB);
        if (reg < 2 && (cc & 63) == 0) {
            const float cs = rope[PAST * 16 + (c & 7)], sn = rope[PAST * 16 + 8 + (c & 7)];
#pragma unroll
            for (int g = 0; g < 4; ++g) { const float p = dppf<0x128>(cA[g]); cA[g] = c < 8 ? cA[g] * cs - p * sn : cA[g] * cs + p * sn; }
        }
        float* dst = reg == 0 ? QS : (reg == 1 ? out + OFF_KS : out + OFF_VS); const float sc = reg == 0 ? QSCALE : 1.0f;
#pragma unroll
        for (int g = 0; g < 4; ++g) { st_wt(dst + (size_t)(r0 + g) * CCH + cc + c, cA[g] * sc); st_wt(dst + (size_t)(r0 + g) * CCH + cc + 16 + c, cB[g] * sc); }
    }
}
template <int K> __device__ __forceinline__ void dres_unit(const Frame& F, int j, const bf16* A, const bf16* Bt, const float* base, const float* gate, float* dst) {
    f32x4 cA, cB; const int c = F.lane & 15, r0 = 16 * F.wave + 4 * (F.lane >> 4), n = 32 * j + c;
    dgemm_unit<K>(F, A, Bt, 32 * j, 32 * j + 16, cA, cB);
#pragma unroll
    for (int g = 0; g < 4; ++g) { const int r = r0 + g; const float* gr = gate + (size_t)(2 + r) * NMOD;
        st_wt(dst + (size_t)r * DM + n, base[(size_t)r * DM + n] + gr[n] * cA[g]); st_wt(dst + (size_t)r * DM + n + 16, base[(size_t)r * DM + n + 16] + gr[n + 16] * cB[g]); }
}
__device__ __forceinline__ void d3_unit(const Frame& F, int j, const bf16* XN2d, const bf16* WfiT, bf16* ACTd) {
    f32x4 cA, cB; const int c = F.lane & 15, r0 = 16 * F.wave + 4 * (F.lane >> 4), nA = ((j >> 3) << 8) + ((j & 7) << 4);
    dgemm_unit<DM>(F, XN2d, WfiT, nA, nA + 128, cA, cB);
#pragma unroll
    for (int g = 0; g < 4; ++g) st_wt(ACTd + (size_t)(r0 + g) * DFF + 16 * j + c, f2bf(silu_f(cA[g]) * cB[g]));
}
__device__ __forceinline__ void dn2_unit(const Frame& F, int u, const float* X1d, const float* gain, const float* mods, bf16* XN2d) {
    const int r = 8 * u + F.wave; const float* mrow = mods + (size_t)(2 + r) * NMOD;
    const GAS f32x4* xr = (const GAS f32x4*)(X1d + (size_t)r * DM) + F.lane;
    f32x4 v[4]; float s = 0.f;
#pragma unroll
    for (int j = 0; j < 4; ++j) { v[j] = xr[64 * j]; s += (v[j].x * v[j].x + v[j].y * v[j].y) + (v[j].z * v[j].z + v[j].w * v[j].w); }
    const float rstd = 1.0f / sqrtf(wave_sum(s) * (1.f / DM) + NORM_EPS);
#pragma unroll
    for (int j = 0; j < 4; ++j) { const int col = 4 * (F.lane + 64 * j);
        const f32x4 g = *(const GAS f32x4*)(gain + col), sc = *(const GAS f32x4*)(mrow + MOD_SC_F + col), sh = *(const GAS f32x4*)(mrow + MOD_SH_F + col);
        const f32x4 o = v[j] * rstd * g * (sc + 1.0f) + sh;
        st_wt64(XN2d + (size_t)r * DM + col, (unsigned long long)pk2(o.x, o.y) | ((unsigned long long)pk2(o.z, o.w) << 32)); }
}
__device__ __forceinline__ void df_unit(const Frame& F, int u, float* yd, const float* gain) {
    GAS f32x4* xr = (GAS f32x4*)(yd + (size_t)(8 * u + F.wave) * DM) + F.lane;
    f32x4 v[4]; float s = 0.f;
#pragma unroll
    for (int j = 0; j < 4; ++j) { v[j] = xr[64 * j]; s += (v[j].x * v[j].x + v[j].y * v[j].y) + (v[j].z * v[j].z + v[j].w * v[j].w); }
    const float rstd = 1.0f / sqrtf(wave_sum(s) * (1.f / DM) + NORM_EPS);
#pragma unroll
    for (int j = 0; j < 4; ++j) xr[64 * j] = v[j] * rstd * *(const GAS f32x4*)(gain + 4 * (F.lane + 64 * j));
}
__device__ __forceinline__ int q_pull(const Frame& F, gu32* head, LAS unsigned* slot) {
    if (F.tid == 0) *slot = __hip_atomic_fetch_add(head, 1u, RLX_AGENT);
    __syncthreads(); const int t = (int)*slot; __syncthreads(); return t;
}
__global__ void __launch_bounds__(NWAVES * 64, 2) mk_fwd(Args args) {
    extern __shared__ __attribute__((aligned(16))) unsigned char lds[];
    Frame F;
    F.lds = (LAS unsigned char*)lds;
    volatile LAS unsigned* MISC = (volatile LAS unsigned*)(F.lds + MISC_OFF);
    F.tid = threadIdx.x; F.lane = F.tid & 63; F.wave = __builtin_amdgcn_readfirstlane(F.tid >> 6);
    F.G = gridDim.x; { const int bx = blockIdx.x; F.vcu = (F.G % 8 == 0) ? (bx % 8) * (F.G / 8) + bx / 8 : bx; }
    unsigned char* ws = args.ws;
    gu32* ctl = (gu32*)(ws + WS_CTL);
    for (int u = F.tid; u < (LDS_BYTES - LDSCTL_OFF) / 4; u += NWAVES * 64) ((LAS unsigned*)(F.lds + LDSCTL_OFF))[u] = 0u;
    __syncthreads();
    LAS unsigned long long* PT = (LAS unsigned long long*)(F.lds + LDSCTL_OFF);
    if (F.tid == 0) {
#pragma unroll
        for (int i = 0; i < 26; ++i) PT[i] = (unsigned long long)args.in[i];
    }
    __syncthreads();
#define PIN(i) ((const float*)ldptr(PT, (i)))
    XcdBarrier bar; bar.bar = (unsigned*)(ctl + CW_BAR); bar.x = 0; bar.st = nullptr;
    if (args.one) bar = xcd_barrier_post((unsigned*)(ctl + CW_BAR), MISC + 8);
    const int lo = args.ph_lo, hi = args.ph_hi;
#define IN(k) (lo <= (k) && (k) < hi)
#define RETID() do { int t_ = threadIdx.x; asm volatile("" : "+v"(t_)); F.tid = t_; F.lane = t_ & 63; F.wave = __builtin_amdgcn_readfirstlane(t_ >> 6); } while (0)
#define SEAM(k) do { if (IN(k) && IN((k) + 1)) xcd_barrier(bar); } while (0)
    float* out = args.out;
    const float* mods = (const float*)(ws + WS_MODS);
    bf16* XN = (bf16*)(ws + WS_XN); bf16* A2 = (bf16*)(ws + WS_A2); float* X1 = (float*)(ws + WS_X1); bf16* ACT = (bf16*)(ws + WS_ACT);

    if (IN(0)) { RETID(); phase0(F, PT, ws); } SEAM(0);
    if (IN(1)) { RETID(); modnorm_phase(F, PIN(I_XP), PIN(I_XS), PIN(I_GMIX), mods, MOD_SH_M, MOD_SC_M, XN, MR); } SEAM(1);
    if (IN(2)) { RETID();
        pg8::Gemm g{XN, (const bf16*)(ws + WS_WIN), MP, IN_W, DM}; pg8::StaticOrder S; S.init(MP, IN_W, F.G, (int)blockIdx.x);
        pg8::EpiIn E{(bf16*)(ws + WS_U), (bf16*)(ws + WS_Q), (bf16*)(ws + WS_K), (bf16*)(ws + WS_V), out, (const float*)(ws + WS_ROPE)};
        pg8::gemm_phase<pg8::EpiIn, pg8::StaticOrder, PG8_ALIGN, PG8_SP2>(F.lds + RING_OFF, g, S, E);
    } SEAM(2);
    if (IN(3)) {
        static_assert(attn_body::ATTN_LDS_BYTES <= RING_BYTES, "attention body LDS vs frame");
        LAS unsigned* slot = (LAS unsigned*)(F.lds + LDSCTL_OFF + 256);
        gu32* qset = ctl + args.p3set * 1024; gu32* qa = qset + CW_QA; gu32* qd = qset + CW_QD; gu32* stc = qset + CW_ST; gu32* tmo = ctl + CW_TMO;
        const bool dec_first = (F.vcu % DEC_STRIDE) == 0;
        bool qa_done = (args.p3mode & 1) == 0, qd_done = (args.p3mode & 2) == 0;
        for (;;) {
            RETID();
            int kind = -1, t = 0;
            if (dec_first && !qd_done) { t = q_pull(F, qd, slot); if (t < NQD) kind = 1; else qd_done = true; }
            if (kind < 0 && !qa_done) { t = q_pull(F, qa, slot); if (t < NQA) kind = 0; else qa_done = true; }
            if (kind < 0 && !qd_done) { t = q_pull(F, qd, slot); if (t < NQD) kind = 1; else qd_done = true; }
            if (kind < 0) break;
            if (kind == 0) {
                if (t < NQA_ATT) {
                    const int qb = 31 - (t >> 5), bh = t & 31, ph = bh & 15, hh = ph >> 2, cc = (ph >> 1) & 1, vh = ph & 1;
                    attn_body::attn_unit<8>(bh >> 4, hh * 128 + cc * 64, hh * 128 + cc * 64, hh * 128 + vh * 64, ph * 64, qb, (const attn_body::bf16*)(ws + WS_Q), (const attn_body::bf16*)(ws + WS_K), (const attn_body::bf16*)(ws + WS_V), (attn_body::bf16*)(ws + WS_OP), (char*)lds + RING_OFF);
                } else { const int u = t - NQA_ATT;
                    conv_unit(F, u / (SEQ / 32), u % (SEQ / 32), (const bf16*)(ws + WS_U), PIN(I_DWW), PIN(I_DWB), PIN(I_LNG), PIN(I_LNB), A2, out); }
            } else {
                const bf16* XNd = XN + (size_t)MP * DM; bf16* XN2d = XN + (size_t)MR * DM; float* X1d = X1 + (size_t)MP * DM; bf16* ACTd = ACT + (size_t)MP * DFF; const bf16* A2d = A2 + (size_t)MP * DM;
                if (t < TDA) { d1_unit(F, t - TD1, XNd, (const bf16*)(ws + WS_WIN), (const float*)(ws + WS_ROPE), (float*)(ws + WS_QS), out); stage_signal(F, stc + 64 * 0); }
                else if (t < TD2) { stage_wait(F, stc + 64 * 0, ND1, tmo); const int u = t - TDA;
                    if (u < DB * 4) dec_attn_unit(F, u >> 2, u & 3, PIN(I_CK), PIN(I_CV), (const int*)PIN(I_PT), (const float*)(ws + WS_QS), out, PIN(I_SUBG), ((const float*)(ws + WS_MISC))[0], A2);
                    else dec_conv_unit(F, u - DB * 4, PIN(I_SC), PIN(I_DWW), PIN(I_DWB), PIN(I_LNG), PIN(I_LNB), A2, out);
                    stage_signal(F, stc + 64 * 1); }
                else if (t < TDN) { stage_wait(F, stc + 64 * 1, NDA, tmo); dres_unit<DM>(F, t - TD2, A2d, (const bf16*)(ws + WS_WOUT), PIN(I_XS), mods + MOD_GT_M, X1d); stage_signal(F, stc + 64 * 2); }
                else if (t < TD3) { stage_wait(F, stc + 64 * 2, ND2, tmo); dn2_unit(F, t - TDN, X1d, PIN(I_GFFN), mods, XN2d); stage_signal(F, stc + 64 * 3); }
                else if (t < TD4) { stage_wait(F, stc + 64 * 3, NDN, tmo); d3_unit(F, t - TD3, XN2d, (const bf16*)(ws + WS_WFI), ACTd); stage_signal(F, stc + 64 * 4); }
                else if (t < TDF) { stage_wait(F, stc + 64 * 4, ND3, tmo); dres_unit<DFF>(F, t - TD4, ACTd, (const bf16*)(ws + WS_WFO), X1d, mods + MOD_GT_F, out + OFF_Y + (size_t)MP * DM); stage_signal(F, stc + 64 * 5); }
                else { stage_wait(F, stc + 64 * 5, ND4, tmo); df_unit(F, t - TDF, out + OFF_Y + (size_t)MP * DM, PIN(I_GFIN)); }
            }
        }
    } SEAM(3);
    if (IN(4)) { RETID(); combine_phase(F, (const bf16*)(ws + WS_OP), PIN(I_SUBG), ((const float*)(ws + WS_MISC))[0], A2); } SEAM(4);
    if (IN(5)) { RETID();
        pg8::Gemm g{A2, (const bf16*)(ws + WS_WOUT), MP, DM, DM}; pg8::StaticOrder S; S.init(MP, DM, F.G, (int)blockIdx.x);
        pg8::EpiRes E{PIN(I_XP), mods + MOD_GT_M, X1};
        pg8::gemm_phase<pg8::EpiRes, pg8::StaticOrder, PG8_ALIGN, PG8_SP2>(F.lds + RING_OFF, g, S, E);
    } SEAM(5);
    if (IN(6)) { RETID(); modnorm_phase(F, X1, X1 + (size_t)MP * DM, PIN(I_GFFN), mods, MOD_SH_F, MOD_SC_F, XN, MP); } SEAM(6);
    if (IN(7)) { RETID();
        pg8::Gemm g{XN, (const bf16*)(ws + WS_WFI), MP, 2 * DFF, DM}; pg8::StaticOrder S; S.init(MP, 2 * DFF, F.G, (int)blockIdx.x);
        pg8::EpiSwiglu E{ACT};
        pg8::gemm_phase<pg8::EpiSwiglu, pg8::StaticOrder, PG8_ALIGN, PG8_SP2>(F.lds + RING_OFF, g, S, E);
    } SEAM(7);
    if (IN(8)) { RETID();
        pg8::Gemm g{ACT, (const bf16*)(ws + WS_WFO), MP, DM, DFF}; pg8::StaticOrder S; S.init(MP, DM, F.G, (int)blockIdx.x);
        pg8::EpiRes E{X1, mods + MOD_GT_F, out + OFF_Y};
        pg8::gemm_phase<pg8::EpiRes, pg8::StaticOrder, PG8_ALIGN, PG8_SP2>(F.lds + RING_OFF, g, S, E);
    } SEAM(8);
    if (IN(9)) { RETID(); finalnorm_phase(F, out + OFF_Y, PIN(I_GFIN)); }
#undef IN
#undef SEAM
#undef PIN
#undef RETID
}

extern "C" void kernel_launch(void* const* d_in, const int* in_sizes, int n_in, void* d_out, int out_size, void* d_ws, size_t ws_size, hipStream_t stream) {
    static int grid = 0;
    if (grid == 0) {
        if (n_in != 26 || out_size != OUT_TOTAL || ws_size < WS_END) { fprintf(stderr, "kernel_launch: unexpected problem (n_in %d, out %d, ws %zu); nothing launched\n", n_in, out_size, ws_size); grid = -1; return; }
        int dev = 0, cus = 0, per_cu = 0;
        if (hipGetDevice(&dev) != hipSuccess || hipDeviceGetAttribute(&cus, hipDeviceAttributeMultiprocessorCount, dev) != hipSuccess) { grid = -1; return; }
        if (hipFuncSetAttribute((const void*)mk_fwd, hipFuncAttributeMaxDynamicSharedMemorySize, LDS_BYTES) != hipSuccess) { fprintf(stderr, "kernel_launch: hipFuncSetAttribute failed\n"); grid = -1; return; }
        if (hipOccupancyMaxActiveBlocksPerMultiprocessor(&per_cu, (const void*)mk_fwd, NWAVES * 64, LDS_BYTES) != hipSuccess || per_cu < 1) { fprintf(stderr, "kernel_launch: occupancy query reports %d workgroups per CU\n", per_cu); }
        (void)hipGetLastError();
        grid = cus;
    }
    if (grid < 0) return;
    if (hipMemsetAsync((char*)d_ws + WS_CTL, 0, CTL_ZERO_BYTES, stream) != hipSuccess) return;
    Args a{};
    for (int i = 0; i < 26; ++i) a.in[i] = d_in[i];
    a.out = (float*)d_out; a.ws = (unsigned char*)d_ws;
#if MK_ONE_LAUNCH
    a.ph_lo = 0; a.ph_hi = N_PHASES; a.one = 1; a.p3mode = 3; a.p3set = 0;
    hipLaunchKernelGGL(mk_fwd, dim3(grid), dim3(NWAVES * 64), LDS_BYTES, stream, a);
#else
    for (int p = 0; p < N_PHASES; ++p) { a.ph_lo = p; a.ph_hi = p + 1; a.one = 0; a.p3mode = 3; a.p3set = 0;
        if (p == 3) {
            int set = 0; for (int m = MK_P3_LIST; m > 0; m /= 10) { a.p3mode = m % 10; a.p3set = set++; hipLaunchKernelGGL(mk_fwd, dim3(grid), dim3(NWAVES * 64), LDS_BYTES, stream, a); }
            continue; }
        for (int r = 0; r < (((MK_REPEAT_MASK) >> p) & 1) + 1; ++r) hipLaunchKernelGGL(mk_fwd, dim3(grid), dim3(NWAVES * 64), LDS_BYTES, stream, a); }
#endif
}
```

```cpp
#include <hip/hip_runtime.h>
#include <hip/hip_bf16.h>
#include <cstdio>
#include <cstdint>
#include <cmath>
constexpr int DM = 1024, SEQ = 8192, MP = 16384, DB = 128, MR = MP + DB, MPAD = 16640;
constexpr int CCH = 512, CWID = 31, IN_W = 2560, DFF = 2816, NMOD = 6144, NPAGE = 16, PAGE = 128, PAST = 2048;
constexpr int MOD_SH_M = 0, MOD_SC_M = 1024, MOD_GT_M = 2048, MOD_SH_F = 3072, MOD_SC_F = 4096, MOD_GT_F = 5120;
constexpr int OFF_Y = 0, OFF_KP = 16908288, OFF_VP = 25296896, OFF_CP = 33685504, OFF_KS = 33716224, OFF_VS = 33781760, OFF_CS = 33847296, OUT_TOTAL = 35813376;
constexpr float QSCALE = 0.125f * 1.4426950408889634f;
constexpr float NORM_EPS = 1e-6f, LAM_INIT = 0.2f;
namespace pg8 {
#define PG8_LAS __attribute__((address_space(3)))
typedef unsigned short bf16_t;
typedef short bf16x8 __attribute__((ext_vector_type(8)));
typedef float f32x4 __attribute__((ext_vector_type(4)));
typedef unsigned u32x4 __attribute__((ext_vector_type(4)));
constexpr int BM = 256, BK = 64, HALF = 128, HTB = HALF * BK * 2  , STAGE_BYTES = 8 * HTB, NXCD = 8, WGM = 8;

__host__ __device__ __forceinline__ int lds_byte(int r, int c) { const int st = (r >> 4) * 2 + (c >> 5), rr = r & 15, cc = c & 31, ob = rr * 64 + cc * 2; return st * 1024 + (ob ^ (((ob >> 9) & 1) << 5)); }
__host__ __device__ __forceinline__ void stage_rc(int b, int& R, int& C) { const int st = b / 1024, sb = b % 1024, swz = sb ^ (((sb >> 9) & 1) << 5); R = (st >> 1) * 16 + swz / 64; C = (st & 1) * 32 + (swz % 64) / 2; }
__host__ __device__ __forceinline__ int perm32(int rho) { const int n = rho >> 4, i = rho & 15; return 8 * (i >> 2) + 4 * n + (i & 3); }

struct Unit { int pm, pn; };
struct Gemm { const bf16_t* A; const bf16_t* Bt; int M, N, K; };

struct StaticOrder {
    int nM, nN, nwg, G, c;
    __host__ __device__ void init(int M, int N, int G_, int c_) { nM = M / BM; nN = N / BM; nwg = nM * nN; G = G_; c = c_; }
    __host__ __device__ bool next(int i, Unit& u) const {
        const long L = (long)i * G + c; if (L >= nwg) return false;
        int wgid = (int)L; { const int q = nwg / NXCD, r = nwg % NXCD, xcd = wgid % NXCD, off = wgid / NXCD; wgid = (xcd < r ? xcd * (q + 1) : r * (q + 1) + (xcd - r) * q) + off; }
        const int nig = WGM * nN, gid = wgid / nig, fm = gid * WGM, gsz = (nM - fm) < WGM ? (nM - fm) : WGM;
        u.pm = fm + ((wgid % nig) % gsz); u.pn = (wgid % nig) / gsz; return true;
    }
    __device__ __forceinline__ void a_ready(const Unit&) const {}
    __device__ __forceinline__ void done(const Unit&) const {}
};

__device__ __forceinline__ unsigned cvt_pk_bf16(float lo, float hi) { unsigned r; asm volatile("v_cvt_pk_bf16_f32 %0, %1, %2" : "=v"(r) : "v"(lo), "v"(hi)); return r; }
typedef float f32x2 __attribute__((ext_vector_type(2)));
__device__ __forceinline__ float sigm(float x) { return __builtin_amdgcn_rcpf(1.0f + __expf(-x)); }
__device__ __forceinline__ u32x4 pack8(const f32x4& a, const f32x4& b) { u32x4 w; w.x = cvt_pk_bf16(a[0], a[1]); w.y = cvt_pk_bf16(a[2], a[3]); w.z = cvt_pk_bf16(b[0], b[1]); w.w = cvt_pk_bf16(b[2], b[3]); return w; }
struct EpiIn {
    static constexpr bool PERM = true, AFTER_DRAIN = false;
    bf16_t *U, *Q, *K, *V; float* out; const float* rope;
    __device__ __forceinline__ void operator()(const f32x4 (&acc)[2][2][4][2], const Unit& u, int wr, int wc, int fr, int fq) const {
        const int row0 = u.pm * BM + wr * 64 + fr, cw = wc * 32 + 8 * fq;
        if (u.pn < 4) {
#pragma unroll
            for (int ai = 0; ai < 2; ++ai) {
#pragma unroll
                for (int m = 0; m < 4; ++m) { const int row = row0 + ai * HALF + m * 16;
                    f32x4 a0 = acc[ai][0][m][0], a1 = acc[ai][0][m][1]; const f32x4 g0 = acc[ai][1][m][0], g1 = acc[ai][1][m][1];
#pragma unroll
                    for (int i = 0; i < 4; ++i) { a0[i] *= sigm(g0[i]); a1[i] *= sigm(g1[i]); }
                    *(u32x4*)(U + (size_t)row * CCH + u.pn * 128 + cw) = pack8(a0, a1);
 } }
        } else if (u.pn < 8) {
            const bool isq = u.pn < 6, rot = (wc & 1) == 0; const int cb = ((u.pn - 4) & 1) * 256 + cw;
#pragma unroll
            for (int ai = 0; ai < 2; ++ai) {
#pragma unroll
                for (int m = 0; m < 4; ++m) { const int row = row0 + ai * HALF + m * 16, pos = row & (SEQ - 1);
                    f32x4 c0 = {1.f, 1.f, 1.f, 1.f}, c1 = c0, s0 = {0.f, 0.f, 0.f, 0.f}, s1 = s0;
                    if (rot && fq < 2) { const float* rp = rope + pos * 16; c0 = *(const f32x4*)rp; c1 = *(const f32x4*)(rp + 4); s0 = *(const f32x4*)(rp + 8); s1 = *(const f32x4*)(rp + 12);
                        if (fq == 0) { s0 = -s0; s1 = -s1; } }
#pragma unroll
                    for (int bj = 0; bj < 2; ++bj) { f32x4 v0 = acc[ai][bj][m][0], v1 = acc[ai][bj][m][1];
                        if (rot) { f32x4 p0, p1;
#pragma unroll
                            for (int i = 0; i < 4; ++i) { p0[i] = __shfl_xor(v0[i], 16); p1[i] = __shfl_xor(v1[i], 16); }
                            v0 = v0 * c0 + p0 * s0; v1 = v1 * c1 + p1 * s1; }
                        const int col = cb + bj * HALF;
                        if (isq) { v0 = v0 * QSCALE; v1 = v1 * QSCALE; *(u32x4*)(Q + (size_t)row * CCH + col) = pack8(v0, v1); }
                        else { *(u32x4*)(K + (size_t)row * CCH + col) = pack8(v0, v1);
                            float* ko = out + OFF_KP + (size_t)row * CCH + col; *(f32x4*)ko = v0; *(f32x4*)(ko + 4) = v1; } } } }
        } else {
            const int cb = (u.pn - 8) * 256 + cw;
#pragma unroll
            for (int ai = 0; ai < 2; ++ai) {
#pragma unroll
                for (int m = 0; m < 4; ++m) { const int row = row0 + ai * HALF + m * 16;
#pragma unroll
                    for (int bj = 0; bj < 2; ++bj) { const f32x4 v0 = acc[ai][bj][m][0], v1 = acc[ai][bj][m][1]; const int col = cb + bj * HALF;
                        *(u32x4*)(V + (size_t)row * CCH + col) = pack8(v0, v1);
                        float* vo = out + OFF_VP + (size_t)row * CCH + col; *(f32x4*)vo = v0; *(f32x4*)(vo + 4) = v1; } } }
        }
    }
};
struct EpiRes {
    static constexpr bool PERM = false, AFTER_DRAIN = false;
    const float* bp; const float* gate; float* dst;
    __device__ __forceinline__ void operator()(const f32x4 (&acc)[2][2][4][2], const Unit& u, int wr, int wc, int fr, int fq) const {
        const int row0 = u.pm * BM + wr * 64 + fr, col0 = u.pn * BM + wc * 32 + 4 * fq;
#pragma unroll
        for (int ai = 0; ai < 2; ++ai) {
#pragma unroll
            for (int m = 0; m < 4; ++m) { const int row = row0 + ai * HALF + m * 16;
                const float* br = bp + (size_t)row * DM; const float* gr = gate + (size_t)(row >> 13) * NMOD;
#pragma unroll
                for (int bj = 0; bj < 2; ++bj)
#pragma unroll
                    for (int n = 0; n < 2; ++n) { const int col = col0 + bj * HALF + n * 16;
                        *(f32x4*)(dst + (size_t)row * DM + col) = *(const f32x4*)(br + col) + *(const f32x4*)(gr + col) * acc[ai][bj][m][n]; } } }
    }
};
struct EpiSwiglu {
    static constexpr bool PERM = true, AFTER_DRAIN = false;
    bf16_t* ACT;
    __device__ __forceinline__ void operator()(const f32x4 (&acc)[2][2][4][2], const Unit& u, int wr, int wc, int fr, int fq) const {
        const int row0 = u.pm * BM + wr * 64 + fr, col = u.pn * 128 + wc * 32 + 8 * fq;
#pragma unroll
        for (int ai = 0; ai < 2; ++ai) {
#pragma unroll
            for (int m = 0; m < 4; ++m) { const int row = row0 + ai * HALF + m * 16;
                f32x4 g0 = acc[ai][0][m][0], g1 = acc[ai][0][m][1]; const f32x4 u0 = acc[ai][1][m][0], u1 = acc[ai][1][m][1];
#pragma unroll
                for (int i = 0; i < 4; ++i) { g0[i] = g0[i] * sigm(g0[i]) * u0[i]; g1[i] = g1[i] * sigm(g1[i]) * u1[i]; }
                *(u32x4*)(ACT + (size_t)row * DFF + col) = pack8(g0, g1); } }
    }
};
template <class Epi, class Sched, bool ALIGN_EPI = false, bool SP2 = false>
__device__ __forceinline__ void gemm_phase(PG8_LAS unsigned char* lds, const Gemm g, const Sched& S, const Epi& E) {
    const int tid = threadIdx.x, wid = __builtin_amdgcn_readfirstlane(tid >> 6), lane = tid & 63, wr = wid >> 2, wc = wid & 3, fr = lane & 15, fq = lane >> 4;
    const int K = g.K, nt = K / BK;
    unsigned voffA[2], voffB[2];
#pragma unroll
    for (int i = 0; i < 2; ++i) { int R, C; stage_rc(tid * 16 + i * 8192, R, C); const int Rb = Epi::PERM ? ((R & ~31) + perm32(R & 31)) : R;
        voffA[i] = (unsigned)(R * K + C) * 2u; voffB[i] = (unsigned)(Rb * K + C) * 2u; }
    const size_t kstep = (size_t)(BK * 2);
    const size_t hstep = (size_t)HALF * K * 2;
    const size_t tstep = 2 * hstep;
    const unsigned ldsw = (unsigned)wid * 1024u;
    const int aoff = lds_byte(wr * 64 + fr, fq * 8), boff = lds_byte(wc * 32 + fr, fq * 8);
#define PG8_SA(b, h) (((b) * 2 + (h)) * HTB)
#define PG8_SB(b, h) ((4 + (b) * 2 + (h)) * HTB)
#define PG8_STAGE(bufoff, gbase, voff) do { _Pragma("unroll") for (int _i = 0; _i < 2; ++_i) \
        __builtin_amdgcn_global_load_lds((const unsigned*)((const char*)(gbase) + (voff)[_i]), (PG8_LAS unsigned*)(lds + (bufoff) + ldsw + _i * 8192), 16, 0, 0); } while (0)
#define PG8_LDA(dst, b, h) do { _Pragma("unroll") for (int m = 0; m < 4; ++m) _Pragma("unroll") for (int k = 0; k < 2; ++k) dst[m][k] = *(const PG8_LAS bf16x8*)(lds + PG8_SA(b, h) + aoff + m * 2048 + k * 1024); } while (0)
#define PG8_LDB(dst, b, h) do { _Pragma("unroll") for (int n = 0; n < 2; ++n) _Pragma("unroll") for (int k = 0; k < 2; ++k) dst[n][k] = *(const PG8_LAS bf16x8*)(lds + PG8_SB(b, h) + boff + n * 2048 + k * 1024); } while (0)
#define PG8_MMA(ai, bj, At, Bt) do { __builtin_amdgcn_s_setprio(1); _Pragma("unroll") for (int m = 0; m < 4; ++m) _Pragma("unroll") for (int n = 0; n < 2; ++n) _Pragma("unroll") for (int k = 0; k < 2; ++k) \
        acc[ai][bj][m][n] = __builtin_amdgcn_mfma_f32_16x16x32_bf16(Bt[n][k], At[m][k], acc[ai][bj][m][n], 0, 0, 0); __builtin_amdgcn_s_setprio(0); } while (0)
#define PG8_WAIT_V(n) asm volatile("s_waitcnt vmcnt(" #n ")" ::: "memory")
#define PG8_WAIT_L(n) asm volatile("s_waitcnt lgkmcnt(" #n ")" ::: "memory")
#define PG8_BAR __builtin_amdgcn_s_barrier()
#define PG8_SCHED __builtin_amdgcn_sched_barrier(0)
    Unit cur, nxt; int ui = 0;
    if (!S.next(0, cur)) return;
    f32x4 acc[2][2][4][2];
#pragma unroll
    for (int a = 0; a < 2; ++a)
#pragma unroll
        for (int b = 0; b < 2; ++b)
#pragma unroll
            for (int m = 0; m < 4; ++m)
#pragma unroll
                for (int n = 0; n < 2; ++n) acc[a][b][m][n] = (f32x4){0.f, 0.f, 0.f, 0.f};
    bf16x8 At[4][2], B0[2][2], B1[2][2];
    const char* cA = (const char*)g.A + (size_t)cur.pm * tstep; const char* cB = (const char*)g.Bt + (size_t)cur.pn * tstep;
    S.a_ready(cur);
    if constexpr (SP2) {
        PG8_STAGE(PG8_SB(0, 0), cB, voffB); PG8_STAGE(PG8_SB(0, 1), cB + hstep, voffB); PG8_STAGE(PG8_SA(0, 0), cA, voffA); PG8_STAGE(PG8_SA(0, 1), cA + hstep, voffA);
        if (wr == 1) PG8_BAR;
        PG8_WAIT_V(2); PG8_BAR;
        PG8_STAGE(PG8_SB(1, 0), cB + kstep, voffB); PG8_STAGE(PG8_SA(1, 0), cA + kstep, voffA); PG8_STAGE(PG8_SB(1, 1), cB + hstep + kstep, voffB);
        PG8_WAIT_V(6); PG8_BAR;
    } else {
        PG8_STAGE(PG8_SB(0, 0), cB, voffB); PG8_STAGE(PG8_SA(0, 0), cA, voffA); PG8_STAGE(PG8_SB(0, 1), cB + hstep, voffB); PG8_STAGE(PG8_SA(0, 1), cA + hstep, voffA);
        if (wr == 1) PG8_BAR;
        PG8_WAIT_V(4); PG8_BAR;
        PG8_STAGE(PG8_SB(1, 0), cB + kstep, voffB); PG8_STAGE(PG8_SA(1, 0), cA + kstep, voffA); PG8_STAGE(PG8_SB(1, 1), cB + hstep + kstep, voffB);
        PG8_WAIT_V(6); PG8_BAR;
    }
    for (;;) {
        const bool has_next = S.next(ui + 1, nxt);
        const char* nA = has_next ? (const char*)g.A + (size_t)nxt.pm * tstep : cA; const char* nB = has_next ? (const char*)g.Bt + (size_t)nxt.pn * tstep : cB;
        for (int t = 0; t < nt; t += 2) {
            const bool last = (t == nt - 2);
            const char* a1 = cA + (size_t)(t + 1) * kstep;
            const char* a2 = last ? nA : cA + (size_t)(t + 2) * kstep; const char* b2 = last ? nB : cB + (size_t)(t + 2) * kstep;
            const char* a3 = a2 + kstep; const char* b3 = b2 + kstep;
            if (last && has_next) S.a_ready(nxt);
            if constexpr (SP2) {
            PG8_LDB(B0, 0, 0); PG8_LDB(B1, 0, 1); PG8_SCHED; PG8_LDA(At, 0, 0); PG8_STAGE(PG8_SA(1, 1), a1 + hstep, voffA);
            PG8_WAIT_V(8); PG8_WAIT_L(0); PG8_BAR; PG8_MMA(0, 0, At, B0); PG8_MMA(0, 1, At, B1); PG8_BAR; PG8_SCHED;
            PG8_LDA(At, 0, 1); PG8_STAGE(PG8_SB(0, 0), b2, voffB); PG8_STAGE(PG8_SB(0, 1), b2 + hstep, voffB); PG8_STAGE(PG8_SA(0, 0), a2, voffA);
            PG8_WAIT_V(8); PG8_WAIT_L(0); PG8_BAR; PG8_MMA(1, 0, At, B0); PG8_MMA(1, 1, At, B1); PG8_BAR; PG8_SCHED;
            PG8_LDB(B0, 1, 0); PG8_LDB(B1, 1, 1); PG8_SCHED; PG8_LDA(At, 1, 0); PG8_STAGE(PG8_SA(0, 1), a2 + hstep, voffA);
            PG8_WAIT_V(8); PG8_WAIT_L(0); PG8_BAR; PG8_MMA(0, 0, At, B0); PG8_MMA(0, 1, At, B1); PG8_BAR; PG8_SCHED;
            PG8_LDA(At, 1, 1); PG8_STAGE(PG8_SB(1, 0), b3, voffB); PG8_STAGE(PG8_SB(1, 1), b3 + hstep, voffB); PG8_STAGE(PG8_SA(1, 0), a3, voffA);
            PG8_WAIT_V(8); PG8_WAIT_L(0); PG8_BAR; PG8_MMA(1, 0, At, B0); PG8_MMA(1, 1, At, B1); PG8_BAR; PG8_SCHED;
            } else {
            PG8_LDB(B0, 0, 0); PG8_SCHED; PG8_LDA(At, 0, 0); PG8_STAGE(PG8_SA(1, 1), a1 + hstep, voffA);
            PG8_WAIT_L(8); PG8_BAR; PG8_WAIT_L(0); PG8_MMA(0, 0, At, B0); PG8_BAR; PG8_SCHED;
            PG8_LDB(B1, 0, 1); PG8_STAGE(PG8_SB(0, 0), b2, voffB);
            PG8_BAR; PG8_WAIT_L(0); PG8_MMA(0, 1, At, B1); PG8_BAR;
            PG8_LDA(At, 0, 1); PG8_STAGE(PG8_SA(0, 0), a2, voffA);
            PG8_BAR; PG8_WAIT_L(0); PG8_MMA(1, 0, At, B0); PG8_BAR; PG8_SCHED;
            PG8_STAGE(PG8_SB(0, 1), b2 + hstep, voffB);
            PG8_WAIT_V(6); PG8_BAR; PG8_MMA(1, 1, At, B1); PG8_BAR;
            PG8_LDB(B0, 1, 0); PG8_SCHED; PG8_LDA(At, 1, 0); PG8_STAGE(PG8_SA(0, 1), a2 + hstep, voffA);
            PG8_WAIT_L(8); PG8_BAR; PG8_WAIT_L(0); PG8_MMA(0, 0, At, B0); PG8_BAR; PG8_SCHED;
            PG8_LDB(B1, 1, 1); PG8_STAGE(PG8_SB(1, 0), b3, voffB);
            PG8_BAR; PG8_WAIT_L(0); PG8_MMA(0, 1, At, B1); PG8_BAR;
            PG8_LDA(At, 1, 1); PG8_STAGE(PG8_SA(1, 0), a3, voffA);
            PG8_BAR; PG8_WAIT_L(0); PG8_MMA(1, 0, At, B0); PG8_BAR; PG8_SCHED;
            PG8_STAGE(PG8_SB(1, 1), b3 + hstep, voffB);
            PG8_WAIT_V(6); PG8_BAR; PG8_MMA(1, 1, At, B1); PG8_BAR;
            }
        }
        if constexpr (ALIGN_EPI) { if (wr == 0) PG8_BAR; }
        if constexpr (!Epi::AFTER_DRAIN) { E(acc, cur, wr, wc, fr, fq); S.done(cur); }
        if (!has_next) break;
#pragma unroll
        for (int a = 0; a < 2; ++a)
#pragma unroll
            for (int b = 0; b < 2; ++b)
#pragma unroll
                for (int m = 0; m < 4; ++m)
#pragma unroll
                    for (int n = 0; n < 2; ++n) acc[a][b][m][n] = (f32x4){0.f, 0.f, 0.f, 0.f};
        cur = nxt; cA = nA; cB = nB; ++ui;
        if constexpr (ALIGN_EPI) { if (wr == 1) PG8_BAR; }
    }
    PG8_WAIT_V(0);
    if constexpr (!ALIGN_EPI) { if (wr == 0) PG8_BAR; }
    PG8_BAR;
    if constexpr (Epi::AFTER_DRAIN) { E.fused(acc, cur, wr, wc, fr, fq, lds, wid, lane); S.done(cur); }
#undef PG8_SA
#undef PG8_SB
#undef PG8_STAGE
#undef PG8_LDA
#undef PG8_LDB
#undef PG8_MMA
#undef PG8_WAIT_V
#undef PG8_WAIT_L
#undef PG8_BAR
#undef PG8_SCHED
}
}

#ifndef PG8_SP2
#define PG8_SP2 true
#endif
#ifndef PG8_ALIGN
#define PG8_ALIGN true
#endif
#include <hip/hip_bf16.h>
#include <cmath>
namespace attn_body {
using bf16=__hip_bfloat16;
using bf16x8=__attribute__((ext_vector_type(8)))short;
using s16x4=__attribute__((ext_vector_type(4)))short;
using f32x16=__attribute__((ext_vector_type(16)))float;
using u32x4=__attribute__((ext_vector_type(4)))unsigned;
constexpr int BATCH=2,NHEAD=16,SEQ=8192,D=64,PQ=512,PO=1024;
constexpr int NW=8,QBLK=32,QB=QBLK*NW,KVBLK=64,NQB=SEQ/QB;
constexpr int ATTN_UNIT_ROWS=QB;
__device__ __forceinline__ int crow(int r,int hi){return (r&3)+8*(r>>2)+4*hi;}
#define SBAR() __builtin_amdgcn_sched_barrier(0)
__device__ __forceinline__ void cmask(f32x16&p0,f32x16&p1,int jb,int qrel,int hi){
  const float NEG=-INFINITY; int kb=64*jb+4*hi;
  #pragma unroll
  for(int r=0;r<16;++r){int kv=kb+(r&3)+8*(r>>2); if(kv>qrel)p0[r]=NEG; if(kv+32>qrel)p1[r]=NEG;}
}

constexpr int NSLOT=3, SLOTB=8192;
constexpr int LDS_K=0, LDS_V=NSLOT*SLOTB, LDS_WS=2*NSLOT*SLOTB, LDS_OST=LDS_WS+NW*64*4, LDS_BYTES=LDS_OST+NW*4096;
constexpr float C2=0.125f*1.4426950408889634f;
__device__ __forceinline__ void glds16(const void*gsrc,unsigned lds_dst){unsigned keep;
  asm volatile("s_mov_b32 %0, m0\n\ts_mov_b32 m0, %2\n\ts_nop 0\n\tglobal_load_lds_dwordx4 %1, off\n\ts_mov_b32 m0, %0":"=&s"(keep):"v"(gsrc),"s"(lds_dst):"memory");}
__device__ __forceinline__ float max3f(float a,float b,float c){float r;asm("v_max3_f32 %0, %1, %2, %3":"=v"(r):"v"(a),"v"(b),"v"(c));return r;}
__device__ __forceinline__ float max2f(float a,float b){float r;asm("v_max_f32_e32 %0, %1, %2":"=v"(r):"v"(a),"v"(b));return r;}
__device__ __forceinline__ float fadd_s(float a,float b){float r;asm("v_add_f32_e32 %0, %1, %2":"=v"(r):"v"(a),"v"(b));return r;}
__device__ __forceinline__ float fsub_s(float a,float b){float r;asm("v_sub_f32_e32 %0, %1, %2":"=v"(r):"v"(a),"v"(b));return r;}
typedef float f32x2_t __attribute__((ext_vector_type(2))); typedef __bf16 bf16x2_t __attribute__((ext_vector_type(2)));
__device__ __forceinline__ unsigned cvtpk_s(float lo,float hi){f32x2_t v={lo,hi};bf16x2_t b=__builtin_convertvector(v,bf16x2_t);return __builtin_bit_cast(unsigned,b);}
#define WAIT_BAR(N) asm volatile("s_waitcnt vmcnt(" #N ") lgkmcnt(0)\n\ts_barrier":::"memory")

__device__ __forceinline__ void qkt(f32x16&p0,f32x16&p1,const char*Kslot,const bf16x8*qr,const f32x16&negm,int r32,int hi){
  const char*kb=Kslot+hi*1024+r32*16;
  #pragma unroll
  for(int d0=0;d0<4;++d0){
    const bf16x8 b0=*reinterpret_cast<const bf16x8*>(kb+d0*2048);
    const bf16x8 b1=*reinterpret_cast<const bf16x8*>(kb+d0*2048+512);
    if(d0==0){p0=__builtin_amdgcn_mfma_f32_32x32x16_bf16(b0,qr[0],negm,0,0,0);p1=__builtin_amdgcn_mfma_f32_32x32x16_bf16(b1,qr[0],negm,0,0,0);}
    else{p0=__builtin_amdgcn_mfma_f32_32x32x16_bf16(b0,qr[d0],p0,0,0,0);p1=__builtin_amdgcn_mfma_f32_32x32x16_bf16(b1,qr[d0],p1,0,0,0);}}
}
typedef __attribute__((address_space(3))) const char* lds_cptr;
typedef short v4i16_t __attribute__((ext_vector_type(4)));
__device__ __forceinline__ void kload8(bf16x8*kf,lds_cptr kp){
  kf[0]=*(const __attribute__((address_space(3))) bf16x8*)(kp);      kf[1]=*(const __attribute__((address_space(3))) bf16x8*)(kp+512);
  kf[2]=*(const __attribute__((address_space(3))) bf16x8*)(kp+2048); kf[3]=*(const __attribute__((address_space(3))) bf16x8*)(kp+2560);
  kf[4]=*(const __attribute__((address_space(3))) bf16x8*)(kp+4096); kf[5]=*(const __attribute__((address_space(3))) bf16x8*)(kp+4608);
  kf[6]=*(const __attribute__((address_space(3))) bf16x8*)(kp+6144); kf[7]=*(const __attribute__((address_space(3))) bf16x8*)(kp+6656);
}
__device__ __forceinline__ void kload2(bf16x8*kf,lds_cptr kp,int j){ kf[2*j]=*(const __attribute__((address_space(3))) bf16x8*)(kp+j*2048); kf[2*j+1]=*(const __attribute__((address_space(3))) bf16x8*)(kp+j*2048+512); }
__device__ __forceinline__ s16x4 vtr(lds_cptr p){ return __builtin_bit_cast(s16x4,__builtin_amdgcn_ds_read_tr16_b64_v4i16((__attribute__((address_space(3))) v4i16_t*)p)); }
__device__ __forceinline__ float rowmax(const f32x16&p0,const f32x16&p1){
  float a=max3f(p0[0],p0[1],p1[0]),b=max3f(p0[2],p0[3],p1[1]);a=max3f(a,p1[2],p1[3]);
  #pragma unroll
  for(int r=4;r<16;r+=4){a=max3f(a,p0[r],p0[r+1]);b=max3f(b,p0[r+2],p0[r+3]);a=max3f(a,p1[r],p1[r+1]);b=max3f(b,p1[r+2],p1[r+3]);}
  const float m=max2f(a,b);
  auto rr=__builtin_amdgcn_permlane32_swap(__float_as_uint(m),__float_as_uint(m),false,false);
  return max2f(__uint_as_float(rr[0]),__uint_as_float(rr[1]));
}
__device__ __forceinline__ void pv(f32x16*o,int vb,bf16x8 pa0,bf16x8 pa1,bf16x8 pa2,bf16x8 pa3){
  #pragma unroll
  for(int d0=0;d0<2;++d0){s16x4 lo[4],hi[4];
    #pragma unroll
    for(int ks=0;ks<4;++ks){
      asm volatile("ds_read_b64_tr_b16 %0,%1 offset:%c2":"=&v"(lo[ks]):"v"(vb),"i"(d0*4096+ks*1024):"memory");
      asm volatile("ds_read_b64_tr_b16 %0,%1 offset:%c2":"=&v"(hi[ks]):"v"(vb),"i"(d0*4096+ks*1024+512):"memory");}
    asm volatile("s_waitcnt lgkmcnt(0)":::"memory");SBAR();
    #define PK(k) (bf16x8){lo[k][0],lo[k][1],lo[k][2],lo[k][3],hi[k][0],hi[k][1],hi[k][2],hi[k][3]}
    o[d0]=__builtin_amdgcn_mfma_f32_32x32x16_bf16(pa0,PK(0),o[d0],0,0,0);
    o[d0]=__builtin_amdgcn_mfma_f32_32x32x16_bf16(pa1,PK(1),o[d0],0,0,0);
    o[d0]=__builtin_amdgcn_mfma_f32_32x32x16_bf16(pa2,PK(2),o[d0],0,0,0);
    o[d0]=__builtin_amdgcn_mfma_f32_32x32x16_bf16(pa3,PK(3),o[d0],0,0,0);
    #undef PK
  }
}

#ifndef ATTN_STORE16
#define ATTN_STORE16(p,v) (*(u32x4*)(p)=(v))
#endif
template<int THRL> __device__ __forceinline__ void attn_unit(int b,int qcol,int kcol,int vcol,int ocol,int qb,const bf16*Q,const bf16*__restrict__ K,const bf16*__restrict__ V,bf16*O,char*shm){
  const int tid=threadIdx.x,lane=tid&63,r32=lane&31,hi=lane>>5; const int wid=__builtin_amdgcn_readfirstlane(tid>>6);
  const long rowbase=(long)b*SEQ; const int q0=qb*QB;
  const bf16*Qw=Q+(rowbase+q0+wid*QBLK)*PQ+qcol;
  const bf16*Kh=K+rowbase*PQ+kcol,*Vh=V+rowbase*PQ+vcol;
  const unsigned lds0=(unsigned)(uintptr_t)shm;
  float*wsf=(float*)(shm+LDS_WS)+wid*64;
  const bf16*ksrc=Kh+(long)lane*PQ+wid*8;
  const bf16*vsrc=Vh+(long)(16*(wid&3)+(lane>>2))*PQ+(wid>>2)*32+(lane&3)*8;
  const unsigned kdst=lds0+LDS_K+wid*1024, vdst=lds0+LDS_V+wid*1024;
  #define DMA_K(t,slot) glds16(ksrc+(long)(t)*KVBLK*PQ,(unsigned)__builtin_amdgcn_readfirstlane(kdst+(slot)))
  #define DMA_V(t,slot) glds16(vsrc+(long)(t)*KVBLK*PQ,(unsigned)__builtin_amdgcn_readfirstlane(vdst+(slot)))
  const int vb0=(int)(lds0+LDS_V)+((lane>>4)&1)*32+(lane&3)*8+(4*hi+((lane&15)>>2))*64;
  const char*Kbase=shm+LDS_K; bf16x8 kf[8];
  const lds_cptr shm3=(lds_cptr)shm; const lds_cptr kp0=shm3+LDS_K+hi*1024+r32*16; const lds_cptr vp0=shm3+LDS_V+((lane>>4)&1)*32+(lane&3)*8+(4*hi+((lane&15)>>2))*64;
  const int NT=(q0+QB)/KVBLK;
  DMA_K(0,0);DMA_V(0,0);DMA_K(1,SLOTB);
  bf16x8 qr[4];
  #pragma unroll
  for(int d0=0;d0<4;++d0)qr[d0]=*reinterpret_cast<const bf16x8*>(&Qw[(long)r32*PQ+d0*16+hi*8]);
  float mhat=0.f,l_reg=0.f;f32x16 o[2];o[0]=f32x16{};o[1]=f32x16{};f32x16 negm=f32x16{};asm volatile("":"+v"(negm));
  const int qrel=wid*QBLK+r32;
  #define CMASK(P0,P1,t) do{int jb_=(t)-(NT-4); if(jb_>=0)cmask(P0,P1,jb_,qrel,hi);}while(0)
  bool resc=false;
  #define START(P0,P1) do{ const float rm=rowmax(P0,P1); resc=false; \
    { const float dl=rm; mhat=fadd_s(mhat,dl); \
      _Pragma("unroll") for(int r=0;r<16;++r){P0[r]=fsub_s(P0[r],dl);P1[r]=fsub_s(P1[r],dl);} \
      _Pragma("unroll") for(int r=0;r<16;++r)negm[r]=-mhat; asm volatile("":"+v"(negm)); } \
    _Pragma("unroll") for(int r=0;r<16;++r)P0[r]=__builtin_amdgcn_exp2f(P0[r]); }while(0)
  #define RESC() do{ if(resc){ asm volatile("s_waitcnt lgkmcnt(0)":::"memory"); \
      _Pragma("unroll") for(int d_=0;d_<2;++d_) _Pragma("unroll") for(int r=0;r<16;++r)o[d_][r]*=wsf[crow(r,hi)]; } }while(0)
  f32x16 pA0,pA1,pB0,pB1;
  int sl_prev=0,sl_cur=0,sl_next=SLOTB;
  #define ROT() do{sl_prev=sl_cur;sl_cur=sl_next;sl_next=(sl_next==(NSLOT-1)*SLOTB)?0:sl_next+SLOTB;}while(0)
  DMA_K(2,2*SLOTB);
  WAIT_BAR(3);
  qkt(pA0,pA1,Kbase,qr,negm,r32,hi);asm volatile("s_nop 15\n\ts_nop 7":"+v"(pA0),"+v"(pA1));CMASK(pA0,pA1,0);
  START(pA0,pA1);
  _Pragma("unroll") for(int r=0;r<16;++r)pA1[r]=__builtin_amdgcn_exp2f(pA1[r]);
  WAIT_BAR(0);
  DMA_K(3,0);DMA_V(1,SLOTB);
  ROT();
  kload8(kf,kp0+sl_cur);
  WAIT_BAR(2);
  s16x4 vlo[8],vhi[8]; u32x4 pw0,pw1,pw2,pw3;
  #define PKW(P,B) cvtpk_s(P[B],P[B+1])
  #define PAF(k) __builtin_bit_cast(bf16x8,pw##k)
  #define VFR(i) (bf16x8){vlo[i][0],vlo[i][1],vlo[i][2],vlo[i][3],vhi[i][0],vhi[i][1],vhi[i][2],vhi[i][3]}
  #define PIN(x) asm volatile("":"+v"(x))
  #define MX3(a,b,c) __builtin_fmaxf(__builtin_fmaxf((a),(b)),(c))
  #define GAPA(MF,A0,A1,A2,A3,W0,W1,PW) do{ MF; sacc+=A0; sacc+=A1; sacc+=A2; sacc+=A3; PIN(sacc); W0; W1; PIN(PW); SBAR(); }while(0)
  #define EX(v) __builtin_amdgcn_exp2f(v)
  #define GAPB(MF,X,B) do{ MF; X[B]=EX(X[B]); X[B+1]=EX(X[B+1]); X[B+2]=EX(X[B+2]); X[B+3]=EX(X[B+3]); PIN(X); SBAR(); }while(0)
  #define VRD(i) do{ vlo[i]=vtr(vp_+(((i)>>2)*4096+((i)&3)*1024)); vhi[i]=vtr(vp_+(((i)>>2)*4096+((i)&3)*1024+512)); }while(0)
  #define KRD(G,j) do{ if(G){ kload2(kf,kp0+sl_next,j); SBAR(); } }while(0)
  #define STEP(C0,C1,P0,P1,t,GK,GV,GL) do{ SBAR(); \
    const lds_cptr vp_=vp0+sl_prev; \
    VRD(0); SBAR(); float sacc=(P0[0]+P0[1]); \
    GAPA(C0=__builtin_amdgcn_mfma_f32_32x32x16_bf16(kf[0],qr[0],negm,0,0,0), P0[2],P0[3],P0[4],P0[5],     pw0[0]=PKW(P0,0), pw0[1]=PKW(P0,2), pw0); \
    VRD(4); SBAR(); GAPA(C1=__builtin_amdgcn_mfma_f32_32x32x16_bf16(kf[1],qr[0],negm,0,0,0), P0[6],P0[7],P0[8],P0[9],     pw0[2]=PKW(P0,4), pw0[3]=PKW(P0,6), pw0); \
    VRD(1); SBAR(); GAPA(C0=__builtin_amdgcn_mfma_f32_32x32x16_bf16(kf[2],qr[1],C0,0,0,0),   P0[10],P0[11],P0[12],P0[13], pw1[0]=PKW(P0,8), pw1[1]=PKW(P0,10), pw1); \
    VRD(5); SBAR(); GAPA(C1=__builtin_amdgcn_mfma_f32_32x32x16_bf16(kf[3],qr[1],C1,0,0,0),   P0[14],P0[15],P1[0],P1[1],   pw1[2]=PKW(P0,12),pw1[3]=PKW(P0,14), pw1); \
    VRD(2); SBAR(); GAPA(C0=__builtin_amdgcn_mfma_f32_32x32x16_bf16(kf[4],qr[2],C0,0,0,0),   P1[2],P1[3],P1[4],P1[5],     pw2[0]=PKW(P1,0), pw2[1]=PKW(P1,2), pw2); \
    VRD(6); SBAR(); GAPA(C1=__builtin_amdgcn_mfma_f32_32x32x16_bf16(kf[5],qr[2],C1,0,0,0),   P1[6],P1[7],P1[8],P1[9],     pw2[2]=PKW(P1,4), pw2[3]=PKW(P1,6), pw2); \
    VRD(3); SBAR(); GAPA(C0=__builtin_amdgcn_mfma_f32_32x32x16_bf16(kf[6],qr[3],C0,0,0,0),   P1[10],P1[11],P1[12],P1[13], pw3[0]=PKW(P1,8), pw3[1]=PKW(P1,10), pw3); \
    VRD(7); SBAR(); GAPA(C1=__builtin_amdgcn_mfma_f32_32x32x16_bf16(kf[7],qr[3],C1,0,0,0),   P1[14],P1[15],0.f,0.f,       pw3[2]=PKW(P1,12),pw3[3]=PKW(P1,14), pw3); \
    l_reg+=sacc; \
    if(GK){DMA_K((t)+3,sl_cur);} if(GV){DMA_V((t)+1,sl_next);} \
    CMASK(C0,C1,t); \
    { float a=MX3(C0[0],C0[1],C1[0]),b=MX3(C0[2],C0[3],C1[1]); a=MX3(a,C1[2],C1[3]); \
      _Pragma("unroll") for(int r=4;r<16;r+=4){a=MX3(a,C0[r],C0[r+1]);b=MX3(b,C0[r+2],C0[r+3]);a=MX3(a,C1[r],C1[r+1]);b=MX3(b,C1[r+2],C1[r+3]);} \
      float rm=__builtin_fmaxf(a,b); { auto rr=__builtin_amdgcn_permlane32_swap(__float_as_uint(rm),__float_as_uint(rm),false,false); rm=__builtin_fmaxf(__uint_as_float(rr[0]),__uint_as_float(rr[1])); } \
      resc=false; \
      if(__builtin_expect(__any(rm>(float)THRL),0)){ const float dl=__builtin_fmaxf(rm,0.f); mhat+=dl; \
        _Pragma("unroll") for(int r=0;r<16;++r){C0[r]-=dl;C1[r]-=dl;} \
        _Pragma("unroll") for(int r=0;r<16;++r)negm[r]=-mhat; asm volatile("":"+v"(negm)); \
        const float f=__builtin_amdgcn_exp2f(-dl); l_reg*=f; if(hi==0)wsf[r32]=f; resc=true; } } \
    SBAR(); \
    GAPB(o[0]=__builtin_amdgcn_mfma_f32_32x32x16_bf16(PAF(0),VFR(0),o[0],0,0,0), C0,0); \
    GAPB(o[1]=__builtin_amdgcn_mfma_f32_32x32x16_bf16(PAF(0),VFR(4),o[1],0,0,0), C0,4); \
    KRD(GL,0); GAPB(o[0]=__builtin_amdgcn_mfma_f32_32x32x16_bf16(PAF(1),VFR(1),o[0],0,0,0), C0,8); \
    KRD(GL,1); GAPB(o[1]=__builtin_amdgcn_mfma_f32_32x32x16_bf16(PAF(1),VFR(5),o[1],0,0,0), C0,12); \
    KRD(GL,2); GAPB(o[0]=__builtin_amdgcn_mfma_f32_32x32x16_bf16(PAF(2),VFR(2),o[0],0,0,0), C1,0); \
    KRD(GL,3); GAPB(o[1]=__builtin_amdgcn_mfma_f32_32x32x16_bf16(PAF(2),VFR(6),o[1],0,0,0), C1,4); \
    GAPB(o[0]=__builtin_amdgcn_mfma_f32_32x32x16_bf16(PAF(3),VFR(3),o[0],0,0,0), C1,8); \
    GAPB(o[1]=__builtin_amdgcn_mfma_f32_32x32x16_bf16(PAF(3),VFR(7),o[1],0,0,0), C1,12); \
    }while(0)
  int t=1;
  #undef CMASK
  #define CMASK(P0,P1,t) do{}while(0)
  for(;t+5<NT;t+=2){
    STEP(pB0,pB1,pA0,pA1,t,true,true,true);     WAIT_BAR(2); RESC(); ROT();
    STEP(pA0,pA1,pB0,pB1,t+1,true,true,true);   WAIT_BAR(2); RESC(); ROT();
  }
  #undef CMASK
  #define CMASK(P0,P1,t) do{int jb_=(t)-(NT-4); if(jb_>=0)cmask(P0,P1,jb_,qrel,hi);}while(0)
  #define ENDW(tt) do{ if((tt)+3<NT){WAIT_BAR(2);} else if((tt)+2<NT){WAIT_BAR(1);} else {WAIT_BAR(0);} }while(0)
  for(;t+1<NT;t+=2){
    STEP(pB0,pB1,pA0,pA1,t,(t+3<NT),(t+1<NT),(t+1<NT));       ENDW(t);   RESC(); ROT();
    STEP(pA0,pA1,pB0,pB1,t+1,(t+4<NT),(t+2<NT),(t+2<NT));     ENDW(t+1); RESC(); ROT();
  }
  STEP(pB0,pB1,pA0,pA1,NT-1,false,false,false); RESC();
  { float sacc=pB0[0]+pB0[1]; _Pragma("unroll") for(int r=2;r<16;++r)sacc+=pB0[r]; _Pragma("unroll") for(int r=0;r<16;++r)sacc+=pB1[r]; l_reg+=sacc;
    pw0=(u32x4){PKW(pB0,0),PKW(pB0,2),PKW(pB0,4),PKW(pB0,6)};pw1=(u32x4){PKW(pB0,8),PKW(pB0,10),PKW(pB0,12),PKW(pB0,14)};pw2=(u32x4){PKW(pB1,0),PKW(pB1,2),PKW(pB1,4),PKW(pB1,6)};pw3=(u32x4){PKW(pB1,8),PKW(pB1,10),PKW(pB1,12),PKW(pB1,14)};
    SBAR(); pv(o,vb0+sl_cur,PAF(0),PAF(1),PAF(2),PAF(3)); }
  #undef PKW
  #undef PAF
  #undef VFR
  #undef PIN
  #undef MX3
  #undef GAPA
  #undef GAPB
  #undef EX
  #undef VRD
  #undef KRD
  #undef STEP
  #undef ENDW
  {auto rr=__builtin_amdgcn_permlane32_swap(__float_as_uint(l_reg),__float_as_uint(l_reg),false,false);l_reg=__uint_as_float(rr[0])+__uint_as_float(rr[1]);}
  if(hi==0)wsf[32+r32]=l_reg;asm volatile("s_waitcnt lgkmcnt(0)":::"memory");
  float rli[16];
  #pragma unroll
  for(int r=0;r<16;++r)rli[r]=__builtin_amdgcn_rcpf(wsf[32+crow(r,hi)]);
  bf16*Ow=O+(rowbase+q0+wid*QBLK)*PO+ocol;
  { bf16*stg=(bf16*)(shm+LDS_OST)+wid*2048;
    #pragma unroll
    for(int r=0;r<16;++r){const int orow=crow(r,hi);
      #pragma unroll
      for(int d0=0;d0<2;++d0)stg[orow*64+d0*32+r32]=__float2bfloat16(o[d0][r]*rli[r]);}
    asm volatile("s_waitcnt lgkmcnt(0)":::"memory");
    #pragma unroll
    for(int i=0;i<4;++i){const int row=i*8+(lane>>3),ch=lane&7; const u32x4 v=*(const u32x4*)(stg+row*64+ch*8); ATTN_STORE16(Ow+(long)row*PO+ch*8,v);} }
  asm volatile("s_waitcnt lgkmcnt(0)\n\ts_barrier":::"memory");
  #undef DMA_K
  #undef DMA_V
  #undef CMASK
  #undef START
  #undef RESC
  #undef ROT
}
constexpr int ATTN_LDS_BYTES=LDS_BYTES;
struct AttnTensors { const bf16* Q; const bf16* K; const bf16* V; bf16* O; };
struct AttnUnit { int bh; int qb; };
struct StaticOrder {
  int vcu;
  __device__ __forceinline__ explicit StaticOrder(int grid,int block):vcu((block%8)*(grid/8)+block/8){}
  __device__ __forceinline__ bool next(int i,AttnUnit&u)const{ if(i>=4)return false; const int s=vcu&7; u.bh=vcu>>3; u.qb=(i==0)?s:(i==1)?15-s:(i==2)?16+s:31-s; return true; }
  __device__ __forceinline__ void a_ready(const AttnUnit&)const{}
  __device__ __forceinline__ void done(const AttnUnit&)const{}
};
template<class Sched,int THRL=8> __device__ __forceinline__ void attn_phase(char*lds,const AttnTensors&T,const Sched&S){
  AttnUnit u;
  for(int i=0;S.next(i,u);++i){ S.a_ready(u); const int ph=u.bh%NHEAD,hh=ph>>2,cc=(ph>>1)&1,vh=ph&1;
    attn_unit<THRL>(u.bh/NHEAD,hh*128+cc*64,hh*128+cc*64,hh*128+vh*64,ph*64,u.qb,T.Q,T.K,T.V,T.O,lds); S.done(u); }
}
#undef SBAR
#undef WAIT_BAR
}
constexpr int NWAVES = 8;
#ifndef MK_ONE_LAUNCH
#define MK_ONE_LAUNCH 1
#endif
constexpr int N_PHASES = 10;
#ifndef MK_DEC_STRIDE
#define MK_DEC_STRIDE 2
#endif
#ifndef MK_DPG
#define MK_DPG 2
#endif
constexpr int DPG = MK_DPG;
constexpr int DEC_STRIDE = MK_DEC_STRIDE;
#ifndef MK_REPEAT_MASK
#define MK_REPEAT_MASK 0
#endif
#ifndef MK_P3_LIST
#define MK_P3_LIST 3
#endif
constexpr size_t MiB = 1u << 20;
constexpr size_t WS_CTL = 0, CTL_ZERO_BYTES = 64 * 1024;
constexpr size_t WS_MODS = 1 * MiB;
constexpr size_t WS_ROPE = 5 * MiB;
constexpr size_t WS_QS = 6 * MiB;
constexpr size_t WS_MISC = 7 * MiB;
constexpr size_t WS_WIN = 8 * MiB, WS_WOUT = 13 * MiB, WS_WFI = 15 * MiB, WS_WFO = 26 * MiB;
constexpr size_t WS_XN = 32 * MiB;
constexpr size_t WS_U = 66 * MiB, WS_Q = 84 * MiB, WS_K = 102 * MiB, WS_V = 120 * MiB;
constexpr size_t WS_OP = 138 * MiB;
constexpr size_t WS_A2 = 172 * MiB;
constexpr size_t WS_X1 = 206 * MiB;
constexpr size_t WS_ACT = 272 * MiB;
constexpr size_t WS_END = 364 * MiB;
static_assert(WS_MODS + (size_t)130 * NMOD * 4 <= WS_ROPE && WS_ROPE + (size_t)8193 * 64 <= WS_QS && WS_WIN + (size_t)IN_W * DM * 2 <= WS_WOUT && WS_WOUT + (size_t)DM * DM * 2 <= WS_WFI &&
              WS_WFI + (size_t)2 * DFF * DM * 2 <= WS_WFO && WS_WFO + (size_t)DM * DFF * 2 <= WS_XN && WS_XN + (size_t)MPAD * DM * 2 <= WS_U && WS_U + (size_t)MPAD * CCH * 2 <= WS_Q &&
              WS_OP + (size_t)MP * DM * 2 <= WS_A2 && WS_A2 + (size_t)MPAD * DM * 2 <= WS_X1 && WS_X1 + (size_t)MPAD * DM * 4 <= WS_ACT && WS_ACT + (size_t)MPAD * DFF * 2 <= WS_END, "d_ws map");
constexpr int CW_TMO = 0, CW_BAR = 4096;
constexpr int CW_QA = 8192, CW_QD = 8256, CW_ST = 8320;
static_assert((CW_ST + 64 * 8 + 3 * 1024) * 4 <= (int)CTL_ZERO_BYTES, "CTL words inside the memset region");
constexpr int RING_OFF = 0, RING_BYTES = 131072;
constexpr int LDSCTL_OFF = RING_BYTES, MISC_OFF = LDSCTL_OFF + 320;
constexpr int LDS_BYTES = 147456;
#define GAS __attribute__((address_space(1)))
#define LAS __attribute__((address_space(3)))
typedef unsigned short bf16;
typedef unsigned v4u __attribute__((ext_vector_type(4)));
typedef float f32x4 __attribute__((ext_vector_type(4)));
typedef short bf16x8 __attribute__((ext_vector_type(8)));
typedef GAS unsigned gu32;
typedef GAS unsigned long long gu64;
#define RLX_AGENT __ATOMIC_RELAXED, __HIP_MEMORY_SCOPE_AGENT
#define LDS_WAIT() asm volatile("s_waitcnt lgkmcnt(0)" ::: "memory")
#define VM_WAIT() asm volatile("s_waitcnt vmcnt(0)" ::: "memory")
__device__ __forceinline__ unsigned long long rt() { return __builtin_amdgcn_s_memrealtime(); }
__device__ __forceinline__ unsigned f2bf(float f) { unsigned u = __builtin_bit_cast(unsigned, f); return (u + 0x7fffu + ((u >> 16) & 1u)) >> 16; }
__device__ __forceinline__ unsigned pk2(float lo, float hi) { return f2bf(lo) | (f2bf(hi) << 16); }

#define XB_TMO      128
#define XB_XCNT(j)  (256  + 64 * (j))
#define XB_XSUB(j)  (1280 + 64 * (j))
#define XB_XGEN(j)  (2304 + 64 * (j))
#define XB_TOP      3328
#define XB_TOPGEN   3392
#define XCD_BAR_WORDS 3456
#define XB_SPIN_CAP (1u << 18)

__device__ __forceinline__ unsigned xb_ld(unsigned* p)              { return __hip_atomic_load(p, __ATOMIC_RELAXED, __HIP_MEMORY_SCOPE_AGENT); }
__device__ __forceinline__ unsigned xb_add(unsigned* p, unsigned v) { return __hip_atomic_fetch_add(p, v, __ATOMIC_RELAXED, __HIP_MEMORY_SCOPE_AGENT); }
__device__ __forceinline__ unsigned xb_xcc_id() { return (unsigned)__builtin_amdgcn_s_getreg((3 << 11) | 20) & 0xFu; }
#define XB_SPIN(cond, bar) do { unsigned _sp = 0; while (cond) { __builtin_amdgcn_s_sleep(1); \
    if ((++_sp & 255u) == 0u) { if (xb_ld(&(bar)[XB_TMO])) break; if (_sp > XB_SPIN_CAP) { atomicAdd(&(bar)[XB_TMO], 1u); break; } } } } while (0)

struct XcdBarrier {
    unsigned* bar; unsigned x;
    volatile LAS unsigned* st;
};

__device__ __forceinline__ XcdBarrier xcd_barrier_post(unsigned* bar, volatile LAS unsigned* st) {
    XcdBarrier b; b.bar = bar; b.x = xb_xcc_id(); b.st = st;
    if (threadIdx.x == 0) (void)xb_add(&bar[XB_XCNT(b.x)], 1u);
    return b;
}
__device__ __forceinline__ void xcd_barrier_complete(unsigned* bar, unsigned x, unsigned& nloc, unsigned& nx) {
    const unsigned G = gridDim.x * gridDim.y * gridDim.z;
    unsigned sum, cnt, mine, sp = 0u;
    for (;;) {
        sum = 0u; cnt = 0u; mine = 0u;
#pragma unroll
        for (unsigned j = 0; j < 16; ++j) { const unsigned c = xb_ld(&bar[XB_XCNT(j)]); sum += c; cnt += (c > 0u) ? 1u : 0u; mine = (j == x) ? c : mine; }
        if (sum == G) break;
        __builtin_amdgcn_s_sleep(1);
        if ((++sp & 255u) == 0u) { if (xb_ld(&bar[XB_TMO])) break; if (sp > XB_SPIN_CAP) { atomicAdd(&bar[XB_TMO], 1u); break; } }
    }
    nloc = mine > 0u ? mine : 1u; nx = cnt > 0u ? cnt : 1u;
}

__device__ __forceinline__ void xcd_barrier(const XcdBarrier& b) {
    asm volatile("s_waitcnt vmcnt(0)" ::: "memory");
    __syncthreads();
    if (threadIdx.x == 0) {
        unsigned* bar = b.bar;
        __builtin_amdgcn_s_waitcnt(0);
        unsigned nloc = b.st[0], nx = b.st[1];
        if (nloc == 0u) { xcd_barrier_complete(bar, b.x, nloc, nx); b.st[0] = nloc; b.st[1] = nx; }
        const unsigned old = xb_add(&bar[XB_XSUB(b.x)], 1u);
        const unsigned gen = old / nloc;
        if (old + 1u == (gen + 1u) * nloc) {
            __builtin_amdgcn_fence(__ATOMIC_RELEASE, "agent");
            asm volatile("s_waitcnt vmcnt(0)" ::: "memory");
            const unsigned og = xb_add(&bar[XB_TOP], 1u);
            const unsigned tg = og / nx;
            if (og + 1u == (tg + 1u) * nx) xb_add(&bar[XB_TOPGEN], 1u);
            else XB_SPIN(xb_ld(&bar[XB_TOPGEN]) == tg, bar);
            __builtin_amdgcn_fence(__ATOMIC_ACQUIRE, "agent");
            xb_add(&bar[XB_XGEN(b.x)], 1u);
            asm volatile("s_waitcnt vmcnt(0)" ::: "memory");
        } else {
            XB_SPIN(xb_ld(&bar[XB_XGEN(b.x)]) == gen, bar);
            __builtin_amdgcn_fence(__ATOMIC_ACQUIRE, "agent");
            asm volatile("s_waitcnt vmcnt(0)" ::: "memory");
        }
    }
    __syncthreads();
}

struct Frame { LAS unsigned char* lds; int tid, lane, wave, vcu, G; };
struct Args { const void* in[26]; float* out; unsigned char* ws; int ph_lo, ph_hi, one, p3mode, p3set, pad; };
enum In { I_XP = 0, I_XS, I_CK, I_CV, I_SC, I_PT, I_CP, I_CS, I_GMIX, I_GFFN, I_GFIN, I_WADA, I_BADA, I_WIN, I_DWW, I_DWB, I_LNG, I_LNB, I_LQ1, I_LK1, I_LQ2, I_LK2, I_SUBG, I_WOUT, I_WFI, I_WFO };

__device__ __forceinline__ const void* ldptr(LAS unsigned long long* tab, int i) {
    const unsigned long long v = tab[i]; const unsigned lo = __builtin_amdgcn_readfirstlane((unsigned)v), hi = __builtin_amdgcn_readfirstlane((unsigned)(v >> 32));
    return (const void*)(const GAS void*)(((unsigned long long)hi << 32) | lo);
}
__device__ __forceinline__ float wave_sum(float v) {
#pragma unroll
    for (int o = 1; o < 64; o <<= 1) v += __shfl_xor(v, o);
    return v;
}
__device__ __forceinline__ float wave_max(float v) {
#pragma unroll
    for (int o = 1; o < 64; o <<= 1) v = fmaxf(v, __shfl_xor(v, o));
    return v;
}
template <int CTRL> __device__ __forceinline__ float dppf(float x) { return __int_as_float(__builtin_amdgcn_update_dpp(0, __float_as_int(x), CTRL, 0xf, 0xf, true)); }
__device__ __forceinline__ float row16_sum(float x) {
    x += dppf<0xB1>(x); x += dppf<0x4E>(x); x += dppf<0x141>(x); x += dppf<0x140>(x); return x;
}
__device__ __forceinline__ float bf2f(unsigned short b) { return __uint_as_float((unsigned)b << 16); }
__device__ __forceinline__ void st_wt(float* p, float v) { __hip_atomic_store((GAS unsigned*)p, __float_as_uint(v), RLX_AGENT); }
__device__ __forceinline__ void st_wt(bf16* p, unsigned v) { __hip_atomic_store((GAS unsigned short*)p, (unsigned short)v, RLX_AGENT); }
__device__ __forceinline__ void st_wt64(void* p, unsigned long long v) { __hip_atomic_store((GAS unsigned long long*)p, v, RLX_AGENT); }
__device__ __forceinline__ float block_sum(const Frame& F, LAS float* red, float v) {
    v = wave_sum(v); if (F.lane == 0) red[F.wave] = v; __syncthreads();
    float r = 0.f;
#pragma unroll
    for (int i = 0; i < NWAVES; ++i) r += red[i];
    __syncthreads(); return r;
}
__device__ __forceinline__ float block_max(const Frame& F, LAS float* red, float v) {
    v = wave_max(v); if (F.lane == 0) red[F.wave] = v; __syncthreads();
    float r = red[0];
#pragma unroll
    for (int i = 1; i < NWAVES; ++i) r = fmaxf(r, red[i]);
    __syncthreads(); return r;
}

__device__ __forceinline__ void ada_unit(const Frame& F, int unit, const float* w_ada, const float* b_ada, const float* c_p, const float* c_s, float* mods) {
    constexpr int WST = 1032;
    const int n0 = unit * 32, c4 = F.tid & 7, kp = F.tid >> 3;
    LAS unsigned* Wl32 = (LAS unsigned*)F.lds;
#pragma unroll
    for (int p = 0; p < 8; p += 4) {
        f32x4 a[4], b[4];
#pragma unroll
        for (int q = 0; q < 4; ++q) { const int k = 2 * kp + 128 * (p + q); a[q] = *(const GAS f32x4*)(w_ada + (size_t)k * NMOD + n0 + 4 * c4); b[q] = *(const GAS f32x4*)(w_ada + (size_t)(k + 1) * NMOD + n0 + 4 * c4); }
#pragma unroll
        for (int q = 0; q < 4; ++q) { const int k = 2 * kp + 128 * (p + q);
#pragma unroll
            for (int i = 0; i < 4; ++i) Wl32[((4 * c4 + i) * WST + k) >> 1] = pk2(a[q][i], b[q][i]); }
    }
    __syncthreads();
    const int fr = F.lane & 15, fq = F.lane >> 4;
    for (int mt = F.wave; mt < 9; mt += NWAVES) {
        f32x4 acc0 = {0.f, 0.f, 0.f, 0.f}, acc1 = acc0;
        const int r = mt * 16 + fr;
        const float* crow = r < 2 ? c_p + (size_t)r * DM : c_s + (size_t)(r < 130 ? r - 2 : 0) * DM;
        const bool live = r < 130;
#pragma unroll 4
        for (int s = 0; s < 32; ++s) { const int k = 32 * s + 8 * fq;
            f32x4 x0 = *(const GAS f32x4*)(crow + k), x1 = *(const GAS f32x4*)(crow + k + 4);
#pragma unroll
            for (int i = 0; i < 4; ++i) { x0[i] = live ? x0[i] * __builtin_amdgcn_rcpf(1.0f + __expf(-x0[i])) : 0.f; x1[i] = live ? x1[i] * __builtin_amdgcn_rcpf(1.0f + __expf(-x1[i])) : 0.f; }
            v4u aw; aw.x = pk2(x0[0], x0[1]); aw.y = pk2(x0[2], x0[3]); aw.z = pk2(x1[0], x1[1]); aw.w = pk2(x1[2], x1[3]);
            const bf16x8 A = __builtin_bit_cast(bf16x8, aw);
            const bf16x8 B0 = *(const LAS bf16x8*)(F.lds + ((size_t)fr * WST + k) * 2), B1 = *(const LAS bf16x8*)(F.lds + ((size_t)(16 + fr) * WST + k) * 2);
            acc0 = __builtin_amdgcn_mfma_f32_16x16x32_bf16(A, B0, acc0, 0, 0, 0); acc1 = __builtin_amdgcn_mfma_f32_16x16x32_bf16(A, B1, acc1, 0, 0, 0); }
        const float bb0 = b_ada[n0 + fr], bb1 = b_ada[n0 + 16 + fr];
#pragma unroll
        for (int g = 0; g < 4; ++g) { const int rr = mt * 16 + 4 * fq + g; if (rr < 130) { mods[(size_t)rr * NMOD + n0 + fr] = acc0[g] + bb0; mods[(size_t)rr * NMOD + n0 + 16 + fr] = acc1[g] + bb1; } }
    }
    __syncthreads();
}
__device__ __forceinline__ void p0_transpose_item(const float* W, int K, int N, bf16* WT, int drow0, LAS float* scr, int kb, int nb, int lane) {
    const int k0 = 64 * kb, n0 = 32 * nb;
#pragma unroll 8
    for (int i = 0; i < 32; ++i) { const int kk = 2 * i + (lane >> 5); scr[kk * 33 + (lane & 31)] = W[(size_t)(k0 + kk) * N + n0 + (lane & 31)]; }
    LDS_WAIT(); asm volatile("" ::: "memory");
    const int c = lane & 7;
#pragma unroll
    for (int j = 0; j < 4; ++j) { const int n = (lane >> 3) + 8 * j; const LAS float* s = scr + (8 * c) * 33 + n;
        v4u o; o.x = pk2(s[0 * 33], s[1 * 33]); o.y = pk2(s[2 * 33], s[3 * 33]); o.z = pk2(s[4 * 33], s[5 * 33]); o.w = pk2(s[6 * 33], s[7 * 33]);
        *(GAS v4u*)(WT + (size_t)(drow0 + n) * K + k0 + 8 * c) = o; }
    LDS_WAIT(); asm volatile("" ::: "memory");
}
__device__ __forceinline__ int glu_row(int n0, int half) { return n0 < half ? ((n0 >> 7) << 8) + (n0 & 127) : (((n0 - half) >> 7) << 8) + 128 + ((n0 - half) & 127); }
__device__ __forceinline__ void phase0(const Frame& F, LAS unsigned long long* PT, unsigned char* ws) {
    for (int unit = F.vcu; unit < NMOD / 32; unit += F.G) ada_unit(F, unit, (const float*)ldptr(PT, I_WADA), (const float*)ldptr(PT, I_BADA), (const float*)ldptr(PT, I_CP), (const float*)ldptr(PT, I_CS), (float*)(ws + WS_MODS));
    LAS float* scr = (LAS float*)(F.lds + RING_OFF + F.wave * 16384);
    const int gw = F.vcu * NWAVES + F.wave, NGW = F.G * NWAVES;
    constexpr int I_IN = 16 * (IN_W / 32), I_OUT = 16 * (DM / 32), I_FI = 16 * (2 * DFF / 32), I_FO = (DFF / 64) * (DM / 32), NITEMS = I_IN + I_OUT + I_FI + I_FO;
    for (int it = gw; it < NITEMS; it += NGW) {
        int r = it;
        if (r < I_IN) { const int kb = r / (IN_W / 32), nb = r % (IN_W / 32), n0 = nb * 32; p0_transpose_item((const float*)ldptr(PT, I_WIN), DM, IN_W, (bf16*)(ws + WS_WIN), n0 < 2 * CCH ? glu_row(n0, CCH) : n0, scr, kb, nb, F.lane); continue; } r -= I_IN;
        if (r < I_OUT) { const int kb = r / (DM / 32), nb = r % (DM / 32); p0_transpose_item((const float*)ldptr(PT, I_WOUT), DM, DM, (bf16*)(ws + WS_WOUT), nb * 32, scr, kb, nb, F.lane); continue; } r -= I_OUT;
        if (r < I_FI) { const int kb = r / (2 * DFF / 32), nb = r % (2 * DFF / 32); p0_transpose_item((const float*)ldptr(PT, I_WFI), DM, 2 * DFF, (bf16*)(ws + WS_WFI), glu_row(nb * 32, DFF), scr, kb, nb, F.lane); continue; } r -= I_FI;
        { const int kb = r / (DM / 32), nb = r % (DM / 32); p0_transpose_item((const float*)ldptr(PT, I_WFO), DFF, DM, (bf16*)(ws + WS_WFO), nb * 32, scr, kb, nb, F.lane); }
    }
    float* rope = (float*)(ws + WS_ROPE);
    for (int idx = F.vcu * (NWAVES * 64) + F.tid; idx < 8193 * 8; idx += F.G * NWAVES * 64) {
        const int pos = idx >> 3, i = idx & 7;
        const float inv = i == 0 ? 1.0f : i == 1 ? 0.1939227432012558f : i == 2 ? 0.03760603070259094f : i == 3 ? 0.007292664609849453f : i == 4 ? 0.0014142135623842478f : i == 5 ? 0.00027424818836152554f : i == 6 ? 5.3182957344688475e-05f : 1.0313385246263351e-05f;
        const float angf = __fmul_rn((float)pos, inv);
        const double x = (double)angf, n = rint(x * 0.15915494309189535);
        double rr = fma(-n, 6.283185307179586, x); rr = fma(-n, 2.4492935982947064e-16, rr);
        const double r2 = rr * rr;
        double sn = 1.0 / 25852016738884976640000.0, cs = 1.0 / 620448401733239439360000.0;
        const double fs[11] = {1.0 / 51090942171709440000.0, 1.0 / 121645100408832000.0, 1.0 / 355687428096000.0, 1.0 / 1307674368000.0, 1.0 / 6227020800.0, 1.0 / 39916800.0, 1.0 / 362880.0, 1.0 / 5040.0, 1.0 / 120.0, 1.0 / 6.0, 1.0};
        const double fc[12] = {1.0 / 1124000727777607680000.0, 1.0 / 2432902008176640000.0, 1.0 / 6402373705728000.0, 1.0 / 20922789888000.0, 1.0 / 87178291200.0, 1.0 / 479001600.0, 1.0 / 3628800.0, 1.0 / 40320.0, 1.0 / 720.0, 1.0 / 24.0, 1.0 / 2.0, 1.0};
#pragma unroll
        for (int t = 0; t < 11; ++t) sn = fs[t] - sn * r2;
#pragma unroll
        for (int t = 0; t < 12; ++t) cs = fc[t] - cs * r2;
        sn *= rr;
        rope[pos * 16 + i] = (float)cs; rope[pos * 16 + 8 + i] = (float)sn;
    }
    if (F.vcu == 0 && F.wave == 0) {
        const float s1 = wave_sum(((const float*)ldptr(PT, I_LQ1))[F.lane] * ((const float*)ldptr(PT, I_LK1))[F.lane]), s2 = wave_sum(((const float*)ldptr(PT, I_LQ2))[F.lane] * ((const float*)ldptr(PT, I_LK2))[F.lane]);
        if (F.lane == 0) ((float*)(ws + WS_MISC))[0] = expf(s1) - expf(s2) + LAM_INIT;
    }
}
__device__ __forceinline__ void modnorm_phase(const Frame& F, const float* srcp, const float* srcs, const float* gain, const float* mods, int sh_off, int sc_off, bf16* dst, int nrows) {
    const int gw = F.vcu * NWAVES + F.wave, NGW = F.G * NWAVES;
    for (int m = gw; m < nrows; m += NGW) {
        GAS unsigned long long* o8 = (GAS unsigned long long*)(dst + (size_t)m * DM) + F.lane;
        const float* xrow = m < MP ? srcp + (size_t)m * DM : srcs + (size_t)(m - MP) * DM;
        const float* mrow = mods + (size_t)(m < MP ? (m >> 13) : 2 + m - MP) * NMOD;
        const GAS f32x4* xr = (const GAS f32x4*)xrow + F.lane;
        f32x4 v[4]; float s = 0.f;
#pragma unroll
        for (int j = 0; j < 4; ++j) { v[j] = xr[64 * j]; s += (v[j].x * v[j].x + v[j].y * v[j].y) + (v[j].z * v[j].z + v[j].w * v[j].w); }
        const float rstd = 1.0f / sqrtf(wave_sum(s) * (1.f / DM) + NORM_EPS);
#pragma unroll
        for (int j = 0; j < 4; ++j) { const int col = 4 * (F.lane + 64 * j);
            const f32x4 g = *(const GAS f32x4*)(gain + col), sc = *(const GAS f32x4*)(mrow + sc_off + col), sh = *(const GAS f32x4*)(mrow + sh_off + col);
            const f32x4 o = v[j] * rstd * g * (sc + 1.0f) + sh;
            o8[64 * j] = (unsigned long long)pk2(o.x, o.y) | ((unsigned long long)pk2(o.z, o.w) << 32); }
    }
}
__device__ __forceinline__ void finalnorm_phase(const Frame& F, float* y, const float* gain) {
    const int gw = F.vcu * NWAVES + F.wave, NGW = F.G * NWAVES;
    for (int m = gw; m < MP; m += NGW) {
        GAS f32x4* xr = (GAS f32x4*)(y + (size_t)m * DM) + F.lane;
        f32x4 v[4]; float s = 0.f;
#pragma unroll
        for (int j = 0; j < 4; ++j) { v[j] = xr[64 * j]; s += (v[j].x * v[j].x + v[j].y * v[j].y) + (v[j].z * v[j].z + v[j].w * v[j].w); }
        const float rstd = 1.0f / sqrtf(wave_sum(s) * (1.f / DM) + NORM_EPS);
#pragma unroll
        for (int j = 0; j < 4; ++j) xr[64 * j] = v[j] * rstd * *(const GAS f32x4*)(gain + 4 * (F.lane + 64 * j));
    }
}
__device__ __forceinline__ void conv_unit(const Frame& F, int b, int tile, const bf16* U, const float* dww, const float* dwb, const float* lng, const float* lnb, bf16* A2, float* out) {
    LAS float* YL = (LAS float*)F.lds;
    const int c = F.tid, t0 = tile * 32; const size_t base = (size_t)b * SEQ;
    float w[CWID];
#pragma unroll
    for (int j = 0; j < CWID; ++j) w[j] = dww[j * CCH + c];
    const float bias = dwb[c];
    float h[CWID];
    h[0] = 0.f;
#pragma unroll
    for (int j = 0; j < CWID - 1; ++j) { const int r = t0 - (CWID - 1) + j; h[j + 1] = r >= 0 ? bf2f(U[(base + r) * CCH + c]) : 0.f; }
    float cur[32];
#pragma unroll
    for (int tt = 0; tt < 32; ++tt) cur[tt] = bf2f(U[(base + t0 + tt) * CCH + c]);
#pragma unroll
    for (int tt = 0; tt < 32; ++tt) {
#pragma unroll
        for (int j = 0; j < CWID - 1; ++j) h[j] = h[j + 1];
        h[CWID - 1] = cur[tt];
        float y = bias;
#pragma unroll
        for (int j = 0; j < CWID; ++j) y = fmaf(w[j], h[j], y);
        YL[tt * CCH + c] = y;
        if (t0 + tt >= SEQ - (CWID - 1)) out[OFF_CP + (size_t)b * (CWID - 1) * CCH + (size_t)(t0 + tt - (SEQ - (CWID - 1))) * CCH + c] = cur[tt];
    }
    __syncthreads();
    const int c0 = 8 * F.lane;
    const f32x4 g0 = *(const GAS f32x4*)(lng + c0), g1 = *(const GAS f32x4*)(lng + c0 + 4), b0 = *(const GAS f32x4*)(lnb + c0), b1 = *(const GAS f32x4*)(lnb + c0 + 4);
#pragma unroll
    for (int q = 0; q < 4; ++q) { const int tt = 4 * F.wave + q;
        f32x4 v0 = *(const LAS f32x4*)(YL + tt * CCH + c0), v1 = *(const LAS f32x4*)(YL + tt * CCH + c0 + 4);
        const float mean = wave_sum((v0.x + v0.y) + (v0.z + v0.w) + (v1.x + v1.y) + (v1.z + v1.w)) * (1.f / CCH);
        v0 = v0 - mean; v1 = v1 - mean;
        const float var = wave_sum((v0.x * v0.x + v0.y * v0.y) + (v0.z * v0.z + v0.w * v0.w) + (v1.x * v1.x + v1.y * v1.y) + (v1.z * v1.z + v1.w * v1.w)) * (1.f / CCH);
        const float rstd = 1.0f / sqrtf(var + NORM_EPS);
        v0 = v0 * rstd * g0 + b0; v1 = v1 * rstd * g1 + b1;
#pragma unroll
        for (int i = 0; i < 4; ++i) { v0[i] *= __builtin_amdgcn_rcpf(1.0f + __expf(-v0[i])); v1[i] *= __builtin_amdgcn_rcpf(1.0f + __expf(-v1[i])); }
        v4u o; o.x = pk2(v0.x, v0.y); o.y = pk2(v0.z, v0.w); o.z = pk2(v1.x, v1.y); o.w = pk2(v1.z, v1.w);
        *(GAS v4u*)(A2 + (base + t0 + tt) * DM + c0) = o; }
    __syncthreads();
}
__device__ __forceinline__ void dec_conv_unit(const Frame& F, int b, const float* state, const float* dww, const float* dwb, const float* lng, const float* lnb, bf16* A2, float* out) {
    LAS float* red = (LAS float*)F.lds;
    const int c = F.tid; const float* st = state + (size_t)b * (CWID - 1) * CCH; float* cs = out + OFF_CS + (size_t)b * (CWID - 1) * CCH;
    float y = dwb[c];
#pragma unroll
    for (int j = 0; j < CWID - 1; ++j) { const float s = st[j * CCH + c]; y = fmaf(dww[j * CCH + c], s, y); if (j >= 1) cs[(j - 1) * CCH + c] = s; }
    y = fmaf(dww[(CWID - 1) * CCH + c], cs[(CWID - 2) * CCH + c], y);
    const float mean = block_sum(F, red, y) * (1.f / CCH), d = y - mean, var = block_sum(F, red, d * d) * (1.f / CCH);
    float v = d * (1.0f / sqrtf(var + NORM_EPS)) * lng[c] + lnb[c]; v *= __builtin_amdgcn_rcpf(1.0f + __expf(-v));
    st_wt(A2 + (size_t)(MP + b) * DM + c, f2bf(v));
}
__device__ __forceinline__ void dec_attn_unit(const Frame& F, int b, int h, const float* ck, const float* cv, const int* ptab, const float* QS, const float* out, const float* subg, float lam, bf16* A2) {
    LAS float* ML = (LAS float*)F.lds;
    LAS float* O1 = ML + 80; LAS float* O2 = O1 + 17 * 128; LAS float* red = O2 + 17 * 128;
    const int lane = F.lane, wave = F.wave, ts = lane >> 5, part = (lane >> 4) & 1, d4 = lane & 15, d4v = lane & 31;
    const int pv = ptab[b * NPAGE + (lane & 15)];
    const f32x4 qv = *(const GAS f32x4*)(QS + (size_t)b * CCH + h * 128 + part * 64 + 4 * d4);
    const size_t koff = (size_t)h * 128 + part * 64 + 4 * d4 + (size_t)(wave * 2 + ts) * 512, voff = (size_t)h * 128 + 4 * d4v + (size_t)(wave * 2 + ts) * 512;
    float m1 = -1e30f, m2 = -1e30f, l1 = 0.f, l2 = 0.f; f32x4 o1 = {0.f, 0.f, 0.f, 0.f}, o2 = o1;
    f32x4 kA[8], vA[8], kB[8], vB[8];
#define DA_LOAD(KB_, VB_, g) do { const int page_ = __builtin_amdgcn_readlane(pv, (g)); const float* kp_ = ck + (size_t)page_ * (PAGE * 512) + koff; const float* vp_ = cv + (size_t)page_ * (PAGE * 512) + voff; \
        _Pragma("unroll") for (int i = 0; i < 8; ++i) { KB_[i] = __builtin_nontemporal_load((const GAS f32x4*)(kp_ + (size_t)i * (16 * 512))); VB_[i] = __builtin_nontemporal_load((const GAS f32x4*)(vp_ + (size_t)i * (16 * 512))); } } while (0)
#define DA_COMP(KB_, VB_) do { float s1_[8], s2_[8]; float bm1 = m1, bm2 = m2; \
        _Pragma("unroll") for (int i = 0; i < 8; ++i) { float p = (qv.x * KB_[i].x + qv.y * KB_[i].y) + (qv.z * KB_[i].z + qv.w * KB_[i].w); p = row16_sum(p); \
            const float q_ = __int_as_float(__builtin_amdgcn_ds_swizzle(__float_as_int(p), 0x401F)); s1_[i] = part ? q_ : p; s2_[i] = part ? p : q_; bm1 = fmaxf(bm1, s1_[i]); bm2 = fmaxf(bm2, s2_[i]); } \
        const float c1 = __builtin_amdgcn_exp2f(m1 - bm1), c2 = __builtin_amdgcn_exp2f(m2 - bm2); m1 = bm1; m2 = bm2; l1 *= c1; l2 *= c2; o1 = o1 * c1; o2 = o2 * c2; \
        _Pragma("unroll") for (int i = 0; i < 8; ++i) { const float e1 = __builtin_amdgcn_exp2f(s1_[i] - m1), e2 = __builtin_amdgcn_exp2f(s2_[i] - m2); l1 += e1; l2 += e2; o1 += VB_[i] * e1; o2 += VB_[i] * e2; } } while (0)
    DA_LOAD(kA, vA, 0);
#pragma unroll 1
    for (int g = 0; g < NPAGE; g += 2) {
        DA_LOAD(kB, vB, g + 1);
        DA_COMP(kA, vA);
        if (g + 2 < NPAGE) DA_LOAD(kA, vA, g + 2);
        DA_COMP(kB, vB);
    }
#undef DA_LOAD
#undef DA_COMP
    { const int p = wave * 2 + ts; if (d4v == 0) { ML[p * 4 + 0] = m1; ML[p * 4 + 1] = l1; ML[p * 4 + 2] = m2; ML[p * 4 + 3] = l2; }
      *(LAS f32x4*)(O1 + p * 128 + 4 * d4v) = o1; *(LAS f32x4*)(O2 + p * 128 + 4 * d4v) = o2; }
    if (wave == 0) {
        const f32x4 kn = *(const GAS f32x4*)(out + OFF_KS + (size_t)b * CCH + h * 128 + part * 64 + 4 * d4);
        float p = (qv.x * kn.x + qv.y * kn.y) + (qv.z * kn.z + qv.w * kn.w); p = row16_sum(p);
        const float q_ = __int_as_float(__builtin_amdgcn_ds_swizzle(__float_as_int(p), 0x401F));
        if (lane == 0) { ML[16 * 4 + 0] = part ? q_ : p; ML[16 * 4 + 1] = 1.f; ML[16 * 4 + 2] = part ? p : q_; ML[16 * 4 + 3] = 1.f; }
        if (lane < 32) { const f32x4 vn = *(const GAS f32x4*)(out + OFF_VS + (size_t)b * CCH + h * 128 + 4 * d4v); *(LAS f32x4*)(O1 + 16 * 128 + 4 * d4v) = vn; *(LAS f32x4*)(O2 + 16 * 128 + 4 * d4v) = vn; }
    }
    __syncthreads();
    float o = 0.f;
    if (F.tid < 128) {
        float M1 = ML[0], M2 = ML[2];
#pragma unroll
        for (int p = 1; p < 17; ++p) { M1 = fmaxf(M1, ML[p * 4]); M2 = fmaxf(M2, ML[p * 4 + 2]); }
        float L1 = 0.f, L2 = 0.f, a1 = 0.f, a2 = 0.f;
#pragma unroll
        for (int p = 0; p < 17; ++p) { const float w1 = __builtin_amdgcn_exp2f(ML[p * 4] - M1), w2 = __builtin_amdgcn_exp2f(ML[p * 4 + 2] - M2);
            L1 = fmaf(ML[p * 4 + 1], w1, L1); L2 = fmaf(ML[p * 4 + 3], w2, L2); a1 = fmaf(O1[p * 128 + F.tid], w1, a1); a2 = fmaf(O2[p * 128 + F.tid], w2, a2); }
        o = a1 / L1 - lam * (a2 / L2);
    }
    const float ss = block_sum(F, red, F.tid < 128 ? o * o : 0.f);
    if (F.tid < 128) st_wt(A2 + (size_t)(MP + b) * DM + CCH + h * 128 + F.tid, f2bf(o * (1.0f / sqrtf(ss * (1.f / 128.f) + NORM_EPS)) * subg[F.tid] * (1.0f - LAM_INIT)));
    __syncthreads();
}
__device__ __forceinline__ void combine_phase(const Frame& F, const bf16* OP, const float* subg, float lam, bf16* A2) {
    const int gw = F.vcu * NWAVES + F.wave, NGW = F.G * NWAVES, hh = F.lane >> 4, d0 = 8 * (F.lane & 15);
    const f32x4 g0 = *(const GAS f32x4*)(subg + d0), g1 = *(const GAS f32x4*)(subg + d0 + 4);
    for (int m = gw; m < MP; m += NGW) {
        const v4u a = *(const GAS v4u*)(OP + (size_t)m * DM + hh * 256 + d0), b = *(const GAS v4u*)(OP + (size_t)m * DM + hh * 256 + 128 + d0);
        float o[8];
#pragma unroll
        for (int i = 0; i < 4; ++i) { o[2 * i] = __uint_as_float(a[i] << 16) - lam * __uint_as_float(b[i] << 16); o[2 * i + 1] = __uint_as_float(a[i] & 0xffff0000u) - lam * __uint_as_float(b[i] & 0xffff0000u); }
        float ss = 0.f;
#pragma unroll
        for (int i = 0; i < 8; ++i) ss += o[i] * o[i];
        const float sc = (1.0f / sqrtf(row16_sum(ss) * (1.f / 128.f) + NORM_EPS)) * (1.0f - LAM_INIT);
        v4u w; w.x = pk2(o[0] * sc * g0.x, o[1] * sc * g0.y); w.y = pk2(o[2] * sc * g0.z, o[3] * sc * g0.w); w.z = pk2(o[4] * sc * g1.x, o[5] * sc * g1.y); w.w = pk2(o[6] * sc * g1.z, o[7] * sc * g1.w);
        *(GAS v4u*)(A2 + (size_t)m * DM + CCH + hh * 128 + d0) = w;
    }
}
constexpr int ND1 = 80, NDA = 640, ND2 = 32, NDN = 16, ND3 = 176, ND4 = 32, NDF = 16;
constexpr int TD1 = 0, TDA = TD1 + ND1, TD2 = TDA + NDA, TDN = TD2 + ND2, TD3 = TDN + NDN, TD4 = TD3 + ND3, TDF = TD4 + ND4, NQD = TDF + NDF;
constexpr int NQA_ATT = 1024, NQA = NQA_ATT + 2 * (SEQ / 32);
__device__ __forceinline__ void stage_wait(const Frame& F, gu32* cnt, unsigned want, gu32* tmo) {
    if (F.wave == 0) {
        unsigned sp = 0;
        while ((unsigned)__builtin_amdgcn_readfirstlane((int)__hip_atomic_load(cnt, RLX_AGENT)) < want) { __builtin_amdgcn_s_sleep(4); if (++sp > (1u << 20)) { if (F.lane == 0) __hip_atomic_store(tmo, 1u, RLX_AGENT); break; } }
        __builtin_amdgcn_fence(__ATOMIC_ACQUIRE, "agent");
    }
    asm volatile("s_waitcnt vmcnt(0)" ::: "memory");
    __syncthreads();
}
__device__ __forceinline__ void stage_signal(const Frame& F, gu32* cnt) {
    asm volatile("s_waitcnt vmcnt(0)" ::: "memory");
    __syncthreads();
    if (F.tid == 0) __hip_atomic_fetch_add(cnt, 1u, RLX_AGENT);
}
template <int K> __device__ __forceinline__ void dgemm_unit(const Frame& F, const bf16* A, const bf16* Bt, int nA, int nB, f32x4& cA, f32x4& cB) {
    constexpr int KW = K / NWAVES, NS = KW / 32;
    static_assert(K % (NWAVES * 32) == 0, "dgemm_unit: K must split into 32-deep steps over 8 waves");
    const int fr = F.lane & 15, fq = F.lane >> 4, kb = F.wave * KW + 8 * fq;
    const bf16* ap = A + (size_t)fr * K + kb; const bf16* bA = Bt + (size_t)(nA + fr) * K + kb; const bf16* bB = Bt + (size_t)(nB + fr) * K + kb;
    f32x4 acc[8][2];
#pragma unroll
    for (int mt = 0; mt < 8; ++mt) { acc[mt][0] = (f32x4){0.f, 0.f, 0.f, 0.f}; acc[mt][1] = (f32x4){0.f, 0.f, 0.f, 0.f}; }
#pragma unroll
    for (int s0 = 0; s0 < NS; s0 += 2) {
        bf16x8 a[2][8], b[2][2];
#pragma unroll
        for (int u = 0; u < 2; ++u) if (s0 + u < NS) {
#pragma unroll
            for (int mt = 0; mt < 8; ++mt) a[u][mt] = *(const GAS bf16x8*)(ap + (size_t)mt * 16 * K + (s0 + u) * 32);
            b[u][0] = *(const GAS bf16x8*)(bA + (s0 + u) * 32); b[u][1] = *(const GAS bf16x8*)(bB + (s0 + u) * 32); }
#pragma unroll
        for (int u = 0; u < 2; ++u) if (s0 + u < NS) {
#pragma unroll
            for (int mt = 0; mt < 8; ++mt) { acc[mt][0] = __builtin_amdgcn_mfma_f32_16x16x32_bf16(a[u][mt], b[u][0], acc[mt][0], 0, 0, 0); acc[mt][1] = __builtin_amdgcn_mfma_f32_16x16x32_bf16(a[u][mt], b[u][1], acc[mt][1], 0, 0, 0); } }
    }
    LAS f32x4* P = (LAS f32x4*)F.lds;
#pragma unroll
    for (int mt = 0; mt < 8; ++mt) { P[((F.wave * 8 + mt) * 2 + 0) * 64 + F.lane] = acc[mt][0]; P[((F.wave * 8 + mt) * 2 + 1) * 64 + F.lane] = acc[mt][1]; }
    __syncthreads();
    cA = P[((0 * 8 + F.wave) * 2 + 0) * 64 + F.lane]; cB = P[((0 * 8 + F.wave) * 2 + 1) * 64 + F.lane];
#pragma unroll
    for (int w = 1; w < NWAVES; ++w) { cA += P[((w * 8 + F.wave) * 2 + 0) * 64 + F.lane]; cB += P[((w * 8 + F.wave) * 2 + 1) * 64 + F.lane]; }
    __syncthreads();
}
__device__ __forceinline__ float silu_f(float x) { return x * __builtin_amdgcn_rcpf(1.0f + __expf(-x)); }
__device__ __forceinline__ void d1_unit(const Frame& F, int j, const bf16* XNd, const bf16* WinT, const float* rope, float* QS, float* out) {
    f32x4 cA, cB; const int c = F.lane & 15, r0 = 16 * F.wave + 4 * (F.lane >> 4);
    if (j < 32) {
        const int nA = ((j >> 3) << 8) + ((j & 7) << 4);
        dgemm_unit<DM>(F, XNd, WinT, nA, nA + 128, cA, cB);
#pragma unroll
        for (int g = 0; g < 4; ++g) st_wt(out + OFF_CS + (size_t)(r0 + g) * ((CWID - 1) * CCH) + (CWID - 2) * CCH + 16 * j + c, cA[g] * __builtin_amdgcn_rcpf(1.0f + __expf(-cB[g])));
    } else {
        const int n0 = 2 * CCH + 32 * (j - 32), col0 = n0 - 2 * CCH, reg = col0 >> 9, cc = col0 & (CCH - 1);
        dgemm_unit<DM>(F, XNd, WinT, n0, n0 + 16, cA, cB);
        if (reg < 2 && (cc & 63) == 0) {
            const float cs = rope[PAST * 16 + (c & 7)], sn = rope[PAST * 16 + 8 + (c & 7)];
#pragma unroll
            for (int g = 0; g < 4; ++g) { const float p = dppf<0x128>(cA[g]); cA[g] = c < 8 ? cA[g] * cs - p * sn : cA[g] * cs + p * sn; }
        }
        float* dst = reg == 0 ? QS : (reg == 1 ? out + OFF_KS : out + OFF_VS); const float sc = reg == 0 ? QSCALE : 1.0f;
#pragma unroll
        for (int g = 0; g < 4; ++g) { st_wt(dst + (size_t)(r0 + g) * CCH + cc + c, cA[g] * sc); st_wt(dst + (size_t)(r0 + g) * CCH + cc + 16 + c, cB[g] * sc); }
    }
}
template <int K> __device__ __forceinline__ void dres_unit(const Frame& F, int j, const bf16* A, const bf16* Bt, const float* base, const float* gate, float* dst) {
    f32x4 cA, cB; const int c = F.lane & 15, r0 = 16 * F.wave + 4 * (F.lane >> 4), n = 32 * j + c;
    dgemm_unit<K>(F, A, Bt, 32 * j, 32 * j + 16, cA, cB);
#pragma unroll
    for (int g = 0; g < 4; ++g) { const int r = r0 + g; const float* gr = gate + (size_t)(2 + r) * NMOD;
        st_wt(dst + (size_t)r * DM + n, base[(size_t)r * DM + n] + gr[n] * cA[g]); st_wt(dst + (size_t)r * DM + n + 16, base[(size_t)r * DM + n + 16] + gr[n + 16] * cB[g]); }
}
__device__ __forceinline__ void d3_unit(const Frame& F, int j, const bf16* XN2d, const bf16* WfiT, bf16* ACTd) {
    f32x4 cA, cB; const int c = F.lane & 15, r0 = 16 * F.wave + 4 * (F.lane >> 4), nA = ((j >> 3) << 8) + ((j & 7) << 4);
    dgemm_unit<DM>(F, XN2d, WfiT, nA, nA + 128, cA, cB);
#pragma unroll
    for (int g = 0; g < 4; ++g) st_wt(ACTd + (size_t)(r0 + g) * DFF + 16 * j + c, f2bf(silu_f(cA[g]) * cB[g]));
}
__device__ __forceinline__ void dn2_unit(const Frame& F, int u, const float* X1d, const float* gain, const float* mods, bf16* XN2d) {
    const int r = 8 * u + F.wave; const float* mrow = mods + (size_t)(2 + r) * NMOD;
    const GAS f32x4* xr = (const GAS f32x4*)(X1d + (size_t)r * DM) + F.lane;
    f32x4 v[4]; float s = 0.f;
#pragma unroll
    for (int j = 0; j < 4; ++j) { v[j] = xr[64 * j]; s += (v[j].x * v[j].x + v[j].y * v[j].y) + (v[j].z * v[j].z + v[j].w * v[j].w); }
    const float rstd = 1.0f / sqrtf(wave_sum(s) * (1.f / DM) + NORM_EPS);
#pragma unroll
    for (int j = 0; j < 4; ++j) { const int col = 4 * (F.lane + 64 * j);
        const f32x4 g = *(const GAS f32x4*)(gain + col), sc = *(const GAS f32x4*)(mrow + MOD_SC_F + col), sh = *(const GAS f32x4*)(mrow + MOD_SH_F + col);
        const f32x4 o = v[j] * rstd * g * (sc + 1.0f) + sh;
        st_wt64(XN2d + (size_t)r * DM + col, (unsigned long long)pk2(o.x, o.y) | ((unsigned long long)pk2(o.z, o.w) << 32)); }
}
__device__ __forceinline__ void df_unit(const Frame& F, int u, float* yd, const float* gain) {
    GAS f32x4* xr = (GAS f32x4*)(yd + (size_t)(8 * u + F.wave) * DM) + F.lane;
    f32x4 v[4]; float s = 0.f;
#pragma unroll
    for (int j = 0; j < 4; ++j) { v[j] = xr[64 * j]; s += (v[j].x * v[j].x + v[j].y * v[j].y) + (v[j].z * v[j].z + v[j].w * v[j].w); }
    const float rstd = 1.0f / sqrtf(wave_sum(s) * (1.f / DM) + NORM_EPS);
#pragma unroll
    for (int j = 0; j < 4; ++j) xr[64 * j] = v[j] * rstd * *(const GAS f32x4*)(gain + 4 * (F.lane + 64 * j));
}
__device__ __forceinline__ int q_pull(const Frame& F, gu32* head, LAS unsigned* slot) {
    if (F.tid == 0) *slot = __hip_atomic_fetch_add(head, 1u, RLX_AGENT);
    __syncthreads(); const int t = (int)*slot; __syncthreads(); return t;
}
__global__ void __launch_bounds__(NWAVES * 64, 2) mk_fwd(Args args) {
    extern __shared__ __attribute__((aligned(16))) unsigned char lds[];
    Frame F;
    F.lds = (LAS unsigned char*)lds;
    volatile LAS unsigned* MISC = (volatile LAS unsigned*)(F.lds + MISC_OFF);
    F.tid = threadIdx.x; F.lane = F.tid & 63; F.wave = __builtin_amdgcn_readfirstlane(F.tid >> 6);
    F.G = gridDim.x; { const int bx = blockIdx.x; F.vcu = (F.G % 8 == 0) ? (bx % 8) * (F.G / 8) + bx / 8 : bx; }
    unsigned char* ws = args.ws;
    gu32* ctl = (gu32*)(ws + WS_CTL);
    for (int u = F.tid; u < (LDS_BYTES - LDSCTL_OFF) / 4; u += NWAVES * 64) ((LAS unsigned*)(F.lds + LDSCTL_OFF))[u] = 0u;
    __syncthreads();
    LAS unsigned long long* PT = (LAS unsigned long long*)(F.lds + LDSCTL_OFF);
    if (F.tid == 0) {
#pragma unroll
        for (int i = 0; i < 26; ++i) PT[i] = (unsigned long long)args.in[i];
    }
    __syncthreads();
#define PIN(i) ((const float*)ldptr(PT, (i)))
    XcdBarrier bar; bar.bar = (unsigned*)(ctl + CW_BAR); bar.x = 0; bar.st = nullptr;
    if (args.one) bar = xcd_barrier_post((unsigned*)(ctl + CW_BAR), MISC + 8);
    const int lo = args.ph_lo, hi = args.ph_hi;
#define IN(k) (lo <= (k) && (k) < hi)
#define RETID() do { int t_ = threadIdx.x; asm volatile("" : "+v"(t_)); F.tid = t_; F.lane = t_ & 63; F.wave = __builtin_amdgcn_readfirstlane(t_ >> 6); } while (0)
#define SEAM(k) do { if (IN(k) && IN((k) + 1)) xcd_barrier(bar); } while (0)
    float* out = args.out;
    const float* mods = (const float*)(ws + WS_MODS);
    bf16* XN = (bf16*)(ws + WS_XN); bf16* A2 = (bf16*)(ws + WS_A2); float* X1 = (float*)(ws + WS_X1); bf16* ACT = (bf16*)(ws + WS_ACT);

    if (IN(0)) { RETID(); phase0(F, PT, ws); } SEAM(0);
    if (IN(1)) { RETID(); modnorm_phase(F, PIN(I_XP), PIN(I_XS), PIN(I_GMIX), mods, MOD_SH_M, MOD_SC_M, XN, MR); } SEAM(1);
    if (IN(2)) { RETID();
        pg8::Gemm g{XN, (const bf16*)(ws + WS_WIN), MP, IN_W, DM}; pg8::StaticOrder S; S.init(MP, IN_W, F.G, (int)blockIdx.x);
        pg8::EpiIn E{(bf16*)(ws + WS_U), (bf16*)(ws + WS_Q), (bf16*)(ws + WS_K), (bf16*)(ws + WS_V), out, (const float*)(ws + WS_ROPE)};
        pg8::gemm_phase<pg8::EpiIn, pg8::StaticOrder, PG8_ALIGN, PG8_SP2>(F.lds + RING_OFF, g, S, E);
    } SEAM(2);
    if (IN(3)) {
        static_assert(attn_body::ATTN_LDS_BYTES <= RING_BYTES, "attention body LDS vs frame");
        LAS unsigned* slot = (LAS unsigned*)(F.lds + LDSCTL_OFF + 256);
        gu32* qset = ctl + args.p3set * 1024; gu32* qa = qset + CW_QA; gu32* qd = qset + CW_QD; gu32* stc = qset + CW_ST; gu32* tmo = ctl + CW_TMO;
        const bool dec_first = (F.vcu % DEC_STRIDE) == 0;
        bool qa_done = (args.p3mode & 1) == 0, qd_done = (args.p3mode & 2) == 0;
        for (;;) {
            RETID();
            int kind = -1, t = 0;
            if (dec_first && !qd_done) { t = q_pull(F, qd, slot); if (t < NQD) kind = 1; else qd_done = true; }
            if (kind < 0 && !qa_done) { t = q_pull(F, qa, slot); if (t < NQA) kind = 0; else qa_done = true; }
            if (kind < 0 && !qd_done) { t = q_pull(F, qd, slot); if (t < NQD) kind = 1; else qd_done = true; }
            if (kind < 0) break;
            if (kind == 0) {
                if (t < NQA_ATT) {
                    const int qb = 31 - (t >> 5), bh = t & 31, ph = bh & 15, hh = ph >> 2, cc = (ph >> 1) & 1, vh = ph & 1;
                    attn_body::attn_unit<8>(bh >> 4, hh * 128 + cc * 64, hh * 128 + cc * 64, hh * 128 + vh * 64, ph * 64, qb, (const attn_body::bf16*)(ws + WS_Q), (const attn_body::bf16*)(ws + WS_K), (const attn_body::bf16*)(ws + WS_V), (attn_body::bf16*)(ws + WS_OP), (char*)lds + RING_OFF);
                } else { const int u = t - NQA_ATT;
                    conv_unit(F, u / (SEQ / 32), u % (SEQ / 32), (const bf16*)(ws + WS_U), PIN(I_DWW), PIN(I_DWB), PIN(I_LNG), PIN(I_LNB), A2, out); }
            } else {
                const bf16* XNd = XN + (size_t)MP * DM; bf16* XN2d = XN + (size_t)MR * DM; float* X1d = X1 + (size_t)MP * DM; bf16* ACTd = ACT + (size_t)MP * DFF; const bf16* A2d = A2 + (size_t)MP * DM;
                if (t < TDA) { d1_unit(F, t - TD1, XNd, (const bf16*)(ws + WS_WIN), (const float*)(ws + WS_ROPE), (float*)(ws + WS_QS), out); stage_signal(F, stc + 64 * 0); }
                else if (t < TD2) { stage_wait(F, stc + 64 * 0, ND1, tmo); const int u = t - TDA;
                    if (u < DB * 4) dec_attn_unit(F, u >> 2, u & 3, PIN(I_CK), PIN(I_CV), (const int*)PIN(I_PT), (const float*)(ws + WS_QS), out, PIN(I_SUBG), ((const float*)(ws + WS_MISC))[0], A2);
                    else dec_conv_unit(F, u - DB * 4, PIN(I_SC), PIN(I_DWW), PIN(I_DWB), PIN(I_LNG), PIN(I_LNB), A2, out);
                    stage_signal(F, stc + 64 * 1); }
                else if (t < TDN) { stage_wait(F, stc + 64 * 1, NDA, tmo); dres_unit<DM>(F, t - TD2, A2d, (const bf16*)(ws + WS_WOUT), PIN(I_XS), mods + MOD_GT_M, X1d); stage_signal(F, stc + 64 * 2); }
                else if (t < TD3) { stage_wait(F, stc + 64 * 2, ND2, tmo); dn2_unit(F, t - TDN, X1d, PIN(I_GFFN), mods, XN2d); stage_signal(F, stc + 64 * 3); }
                else if (t < TD4) { stage_wait(F, stc + 64 * 3, NDN, tmo); d3_unit(F, t - TD3, XN2d, (const bf16*)(ws + WS_WFI), ACTd); stage_signal(F, stc + 64 * 4); }
                else if (t < TDF) { stage_wait(F, stc + 64 * 4, ND3, tmo); dres_unit<DFF>(F, t - TD4, ACTd, (const bf16*)(ws + WS_WFO), X1d, mods + MOD_GT_F, out + OFF_Y + (size_t)MP * DM); stage_signal(F, stc + 64 * 5); }
                else { stage_wait(F, stc + 64 * 5, ND4, tmo); df_unit(F, t - TDF, out + OFF_Y + (size_t)MP * DM, PIN(I_GFIN)); }
            }
        }
    } SEAM(3);
    if (IN(4)) { RETID(); combine_phase(F, (const bf16*)(ws + WS_OP), PIN(I_SUBG), ((const float*)(ws + WS_MISC))[0], A2); } SEAM(4);
    if (IN(5)) { RETID();
        pg8::Gemm g{A2, (const bf16*)(ws + WS_WOUT), MP, DM, DM}; pg8::StaticOrder S; S.init(MP, DM, F.G, (int)blockIdx.x);
        pg8::EpiRes E{PIN(I_XP), mods + MOD_GT_M, X1};
        pg8::gemm_phase<pg8::EpiRes, pg8::StaticOrder, PG8_ALIGN, PG8_SP2>(F.lds + RING_OFF, g, S, E);
    } SEAM(5);
    if (IN(6)) { RETID(); modnorm_phase(F, X1, X1 + (size_t)MP * DM, PIN(I_GFFN), mods, MOD_SH_F, MOD_SC_F, XN, MP); } SEAM(6);
    if (IN(7)) { RETID();
        pg8::Gemm g{XN, (const bf16*)(ws + WS_WFI), MP, 2 * DFF, DM}; pg8::StaticOrder S; S.init(MP, 2 * DFF, F.G, (int)blockIdx.x);
        pg8::EpiSwiglu E{ACT};
        pg8::gemm_phase<pg8::EpiSwiglu, pg8::StaticOrder, PG8_ALIGN, PG8_SP2>(F.lds + RING_OFF, g, S, E);
    } SEAM(7);
    if (IN(8)) { RETID();
        pg8::Gemm g{ACT, (const bf16*)(ws + WS_WFO), MP, DM, DFF}; pg8::StaticOrder S; S.init(MP, DM, F.G, (int)blockIdx.x);
        pg8::EpiRes E{X1, mods + MOD_GT_F, out + OFF_Y};
        pg8::gemm_phase<pg8::EpiRes, pg8::StaticOrder, PG8_ALIGN, PG8_SP2>(F.lds + RING_OFF, g, S, E);
    } SEAM(8);
    if (IN(9)) { RETID(); finalnorm_phase(F, out + OFF_Y, PIN(I_GFIN)); }
#undef IN
#undef SEAM
#undef PIN
#undef RETID
}

extern "C" void kernel_launch(void* const* d_in, const int* in_sizes, int n_in, void* d_out, int out_size, void* d_ws, size_t ws_size, hipStream_t stream) {
    static int grid = 0;
    if (grid == 0) {
        if (n_in != 26 || out_size != OUT_TOTAL || ws_size < WS_END) { fprintf(stderr, "kernel_launch: unexpected problem (n_in %d, out %d, ws %zu); nothing launched\n", n_in, out_size, ws_size); grid = -1; return; }
        int dev = 0, cus = 0, per_cu = 0;
        if (hipGetDevice(&dev) != hipSuccess || hipDeviceGetAttribute(&cus, hipDeviceAttributeMultiprocessorCount, dev) != hipSuccess) { grid = -1; return; }
        if (hipFuncSetAttribute((const void*)mk_fwd, hipFuncAttributeMaxDynamicSharedMemorySize, LDS_BYTES) != hipSuccess) { fprintf(stderr, "kernel_launch: hipFuncSetAttribute failed\n"); grid = -1; return; }
        if (hipOccupancyMaxActiveBlocksPerMultiprocessor(&per_cu, (const void*)mk_fwd, NWAVES * 64, LDS_BYTES) != hipSuccess || per_cu < 1) { fprintf(stderr, "kernel_launch: occupancy query reports %d workgroups per CU\n", per_cu); }
        (void)hipGetLastError();
        grid = cus;
    }
    if (grid < 0) return;
    if (hipMemsetAsync((char*)d_ws + WS_CTL, 0, CTL_ZERO_BYTES, stream) != hipSuccess) return;
    Args a{};
    for (int i = 0; i < 26; ++i) a.in[i] = d_in[i];
    a.out = (float*)d_out; a.ws = (unsigned char*)d_ws;
#if MK_ONE_LAUNCH
    a.ph_lo = 0; a.ph_hi = N_PHASES; a.one = 1; a.p3mode = 3; a.p3set = 0;
    hipLaunchKernelGGL(mk_fwd, dim3(grid), dim3(NWAVES * 64), LDS_BYTES, stream, a);
#else
    for (int p = 0; p < N_PHASES; ++p) { a.ph_lo = p; a.ph_hi = p + 1; a.one = 0; a.p3mode = 3; a.p3set = 0;
        if (p == 3) {
            int set = 0; for (int m = MK_P3_LIST; m > 0; m /= 10) { a.p3mode = m % 10; a.p3set = set++; hipLaunchKernelGGL(mk_fwd, dim3(grid), dim3(NWAVES * 64), LDS_BYTES, stream, a); }
            continue; }
        for (int r = 0; r < (((MK_REPEAT_MASK) >> p) & 1) + 1; ++r) hipLaunchKernelGGL(mk_fwd, dim3(grid), dim3(NWAVES * 64), LDS_BYTES, stream, a); }
#endif
}
```
